# Optimizing an MI355X kernel written in HIP

```python
import jax, jax.numpy as jnp
from jax import lax
import numpy as np

D_MODEL = 2048
BATCH = 4
SEQ = 4096
DEPTH = 4

D_MIX = D_MODEL
D_RG = D_MIX // 2
RG_BLOCKS = 8
RG_BLOCK_W = D_RG // RG_BLOCKS
CONV_W = 4
RG_C = 8.0
D_GLA_V = D_MIX - D_RG
GLA_HEADS = 4
D_GLA_K = D_GLA_V // 2
GLA_HK = D_GLA_K // GLA_HEADS
GLA_HV = D_GLA_V // GLA_HEADS
GLA_RANK = 16
GLA_TAU = 16.0
GLA_CHUNK = 64
D_IN = 2 * D_RG + 2 * D_GLA_K + 2 * D_GLA_V + GLA_RANK
D_FF = 4 * D_MODEL
N_MOD = 6
ADA_STD = 0.2
ALPHA = (2 * DEPTH) ** 0.25
BETA = (8 * DEPTH) ** -0.25
LN_EPS = 1e-5

kernel_name = "hybrid_rglru_gla_deepnorm_adaln"


def _layer_norm(x, g, b):
    xf = x.astype(jnp.float32)
    mu = jnp.mean(xf, axis=-1, keepdims=True)
    var = jnp.mean(jnp.square(xf - mu), axis=-1, keepdims=True)
    return ((xf - mu) * lax.rsqrt(var + LN_EPS) * g + b).astype(x.dtype)


def _causal_conv(x, w, b):
    S = x.shape[1]
    xp = jnp.pad(x, ((0, 0), (CONV_W - 1, 0), (0, 0)))
    y = b + xp[:, 0:S] * w[0]
    for j in range(1, CONV_W):
        y = y + xp[:, j:j + S] * w[j]
    return y


def _rg_lru(x, w_a, b_a, w_x, b_x, lam):
    B, S, _ = x.shape
    xb = x.reshape(B, S, RG_BLOCKS, RG_BLOCK_W)
    r = jax.nn.sigmoid(jnp.einsum('bshi,hij->bshj', xb, w_a).reshape(B, S, D_RG) + b_a)
    i = jax.nn.sigmoid(jnp.einsum('bshi,hij->bshj', xb, w_x).reshape(B, S, D_RG) + b_x)
    f32 = jnp.float32
    log_a = -RG_C * r.astype(f32) * jax.nn.softplus(-lam.astype(f32))
    a = jnp.exp(log_a)
    u = jnp.sqrt(-jnp.expm1(2.0 * log_a)) * i.astype(f32) * x.astype(f32)

    def combine(left, right):
        a1, b1 = left
        a2, b2 = right
        return a1 * a2, a2 * b1 + b2

    _, h = lax.associative_scan(combine, (a, u), axis=1)
    return h.astype(x.dtype)


def _gla(q, k, v, glr, w_g2, b_g2, norm_g, r):
    B, S, _ = q.shape
    C = GLA_CHUNK
    N = S // C
    f32 = jnp.float32
    z = (glr @ w_g2 + b_g2).astype(f32)
    g = jax.nn.log_sigmoid(z) / GLA_TAU
    shp_k = (B, N, C, GLA_HEADS, GLA_HK)
    qf = q.astype(f32).reshape(shp_k) * (GLA_HK ** -0.5)
    kf = k.astype(f32).reshape(shp_k)
    vf = v.astype(f32).reshape(B, N, C, GLA_HEADS, GLA_HV)
    bcum = jnp.cumsum(g.reshape(shp_k), axis=2)
    b_last = bcum[:, :, -1:]
    q_dec = qf * jnp.exp(bcum)
    k_inv = kf * jnp.exp(-bcum)
    k_tail = kf * jnp.exp(b_last - bcum)
    causal = jnp.tril(jnp.ones((C, C), dtype=bool))
    att = jnp.einsum('bnihd,bnjhd->bnhij', q_dec, k_inv)
    att = jnp.where(causal, att, 0.0)
    o_intra = jnp.einsum('bnhij,bnjhv->bnihv', att, vf)
    chunk_update = jnp.einsum('bnjhd,bnjhv->nbhdv', k_tail, vf)
    chunk_decay = jnp.exp(jnp.moveaxis(b_last[:, :, 0], 1, 0))

    def step(state, inp):
        dec, upd = inp
        return dec[..., None] * state + upd, state

    s0 = jnp.zeros((B, GLA_HEADS, GLA_HK, GLA_HV), f32)
    _, s_prev = lax.scan(step, s0, (chunk_decay, chunk_update))
    o_inter = jnp.einsum('bnihd,nbhdv->bnihv', q_dec, s_prev)
    o = (o_intra + o_inter).reshape(B, S, GLA_HEADS, GLA_HV)
    o = o * lax.rsqrt(jnp.mean(o * o, axis=-1, keepdims=True) + LN_EPS)
    o = o.reshape(B, S, D_GLA_V) * norm_g * jax.nn.silu(r.astype(f32))
    return o.astype(q.dtype)


def setup_inputs(seed: int = 0) -> dict:
    key = jax.random.key(seed)
    ks = jax.random.split(key, 24)
    L, D = DEPTH, D_MODEL
    nrm = jax.random.normal
    a_c = jax.random.uniform(ks[11], (L, D_RG), minval=0.9, maxval=0.999)
    s = a_c ** (1.0 / RG_C)
    rg_lambda = jnp.log(s) - jnp.log1p(-s)
    return {
        'x': nrm(ks[0], (BATCH, SEQ, D), jnp.float32),
        'c': nrm(ks[1], (BATCH, D), jnp.float32),
        'w_ada': nrm(ks[2], (L, D, N_MOD * D)) * (D ** -0.5) * ADA_STD,
        'b_ada': nrm(ks[3], (L, N_MOD * D)) * 0.01,
        'w_in': nrm(ks[4], (L, D, D_IN)) * (D ** -0.5),
        'conv_w': nrm(ks[5], (L, CONV_W, D_RG)) * (CONV_W ** -0.5),
        'conv_b': nrm(ks[6], (L, D_RG)) * 0.01,
        'w_rg_a': nrm(ks[7], (L, RG_BLOCKS, RG_BLOCK_W, RG_BLOCK_W)) * (RG_BLOCK_W ** -0.5),
        'b_rg_a': nrm(ks[8], (L, D_RG)) * 0.01,
        'w_rg_x': nrm(ks[9], (L, RG_BLOCKS, RG_BLOCK_W, RG_BLOCK_W)) * (RG_BLOCK_W ** -0.5),
        'b_rg_x': nrm(ks[10], (L, D_RG)) * 0.01,
        'rg_lambda': rg_lambda,
        'w_gla_g2': nrm(ks[12], (L, GLA_RANK, D_GLA_K)) * (GLA_RANK ** -0.5),
        'b_gla_g2': nrm(ks[13], (L, D_GLA_K)) * 0.01,
        'gla_norm_g': 1.0 + 0.02 * nrm(ks[14], (L, D_GLA_V)),
        'w_out': nrm(ks[15], (L, D_MIX, D)) * (D_MIX ** -0.5) * BETA,
        'ln1_g': 1.0 + 0.02 * nrm(ks[16], (L, D)),
        'ln1_b': nrm(ks[17], (L, D)) * 0.01,
        'w_up': nrm(ks[18], (L, D, D_FF)) * (D ** -0.5),
        'b_up': nrm(ks[19], (L, D_FF)) * 0.01,
        'w_down': nrm(ks[20], (L, D_FF, D)) * (D_FF ** -0.5) * BETA,
        'b_down': nrm(ks[21], (L, D)) * 0.01,
        'ln2_g': 1.0 + 0.02 * nrm(ks[22], (L, D)),
        'ln2_b': nrm(ks[23], (L, D)) * 0.01,
    }


def reference(x, c, w_ada, b_ada, w_in, conv_w, conv_b, w_rg_a, b_rg_a, w_rg_x, b_rg_x, rg_lambda,
              w_gla_g2, b_gla_g2, gla_norm_g, w_out, ln1_g, ln1_b, w_up, b_up, w_down, b_down,
              ln2_g, ln2_b):
    splits = [D_RG, 2 * D_RG, 2 * D_RG + D_GLA_K, 2 * D_RG + 2 * D_GLA_K,
              2 * D_RG + 2 * D_GLA_K + D_GLA_V, 2 * D_RG + 2 * D_GLA_K + 2 * D_GLA_V]
    c_act = jax.nn.silu(c)
    for l in range(DEPTH):
        mod = c_act @ w_ada[l] + b_ada[l]
        sh1, sc1, gt1, sh2, sc2, gt2 = [m[:, None, :] for m in jnp.split(mod, N_MOD, axis=-1)]

        u = x * (1.0 + sc1) + sh1
        p = u @ w_in[l]
        rg_x, rg_gate, q, k, v, r, glr = jnp.split(p, splits, axis=-1)
        rg_h = _rg_lru(_causal_conv(rg_x, conv_w[l], conv_b[l]),
                       w_rg_a[l], b_rg_a[l], w_rg_x[l], b_rg_x[l], rg_lambda[l])
        rg_out = rg_h * jax.nn.gelu(rg_gate)
        gla_out = _gla(q, k, v, glr, w_gla_g2[l], b_gla_g2[l], gla_norm_g[l], r)
        mix = jnp.concatenate([rg_out, gla_out], axis=-1) @ w_out[l]
        x = _layer_norm(ALPHA * x + (1.0 + gt1) * mix, ln1_g[l], ln1_b[l])

        u = x * (1.0 + sc2) + sh2
        hdn = jnp.square(jax.nn.relu(u @ w_up[l] + b_up[l]))
        y = hdn @ w_down[l] + b_down[l]
        x = _layer_norm(ALPHA * x + (1.0 + gt2) * y, ln2_g[l], ln2_b[l])
    return x
```

```cpp
#include <hip/hip_runtime.h>
#include <cstdio>
#include <cstdint>
#ifndef MK_LAUNCH_PER_PHASE
#define MK_LAUNCH_PER_PHASE 0
#endif
namespace pg8 {
#define PG8_LAS __attribute__((address_space(3)))
typedef unsigned short bf16_t;
typedef short bf16x8 __attribute__((ext_vector_type(8)));
typedef float f32x4 __attribute__((ext_vector_type(4)));
typedef unsigned u32x4 __attribute__((ext_vector_type(4)));
constexpr int BM = 256, BK = 64, HALF = 128, HTB = HALF * BK * 2  , STAGE_BYTES = 8 * HTB, NXCD = 8, WGM = 8;

__host__ __device__ __forceinline__ int lds_byte(int r, int c) { const int st = (r >> 4) * 2 + (c >> 5), rr = r & 15, cc = c & 31, ob = rr * 64 + cc * 2; return st * 1024 + (ob ^ (((ob >> 9) & 1) << 5)); }
__host__ __device__ __forceinline__ void stage_rc(int b, int& R, int& C) { const int st = b / 1024, sb = b % 1024, swz = sb ^ (((sb >> 9) & 1) << 5); R = (st >> 1) * 16 + swz / 64; C = (st & 1) * 32 + (swz % 64) / 2; }
__host__ __device__ __forceinline__ int perm32(int rho) { const int n = rho >> 4, i = rho & 15; return 8 * (i >> 2) + 4 * n + (i & 3); }

struct Unit { int pm, pn; };
struct Gemm { const bf16_t* A; const bf16_t* Bt; int M, N, K; };

struct StaticOrder {
    int nM, nN, nwg, G, c;
    __host__ __device__ void init(int M, int N, int G_, int c_) { nM = M / BM; nN = N / BM; nwg = nM * nN; G = G_; c = c_; }
    __host__ __device__ bool next(int i, Unit& u) const {
        const long L = (long)i * G + c; if (L >= nwg) return false;
        int wgid = (int)L; { const int q = nwg / NXCD, r = nwg % NXCD, xcd = wgid % NXCD, off = wgid / NXCD; wgid = (xcd < r ? xcd * (q + 1) : r * (q + 1) + (xcd - r) * q) + off; }
        const int nig = WGM * nN, gid = wgid / nig, fm = gid * WGM, gsz = (nM - fm) < WGM ? (nM - fm) : WGM;
        u.pm = fm + ((wgid % nig) % gsz); u.pn = (wgid % nig) / gsz; return true;
    }
    __device__ __forceinline__ void a_ready(const Unit&) const {}
    __device__ __forceinline__ void done(const Unit&) const {}
};

__device__ __forceinline__ unsigned cvt_pk_bf16(float lo, float hi) { unsigned r; asm volatile("v_cvt_pk_bf16_f32 %0, %1, %2" : "=v"(r) : "v"(lo), "v"(hi)); return r; }
typedef float f32x2 __attribute__((ext_vector_type(2)));

template <int ACT> struct EpiBf16 {
    static constexpr bool PERM = true, AFTER_DRAIN = false;
    bf16_t* O; int ldc; const float* bias;
    __device__ __forceinline__ void operator()(const f32x4 (&acc)[2][2][4][2], const Unit& u, int wr, int wc, int fr, int fq) const {
        const int row0 = u.pm * BM + wr * 64 + fr; const int colt = u.pn * BM; bf16_t* base = O;
        const int col0 = colt + wc * 32 + 8 * fq;
        f32x4 bv[2][2];
#pragma unroll
        for (int bj = 0; bj < 2; ++bj)
#pragma unroll
            for (int n = 0; n < 2; ++n) bv[bj][n] = bias ? *(const f32x4*)(bias + col0 + bj * HALF + 4 * n) : (f32x4){0.f, 0.f, 0.f, 0.f};
#pragma unroll
        for (int ai = 0; ai < 2; ++ai)
#pragma unroll
            for (int m = 0; m < 4; ++m) { bf16_t* rowp = base + (size_t)(row0 + ai * HALF + m * 16) * ldc + col0;
#pragma unroll
                for (int bj = 0; bj < 2; ++bj) { f32x4 v0 = acc[ai][bj][m][0] + bv[bj][0], v1 = acc[ai][bj][m][1] + bv[bj][1];
                    if (ACT == 3) {
#pragma unroll
                        for (int j = 0; j < 4; ++j) { const float a = fmaxf(v0[j], 0.f), b = fmaxf(v1[j], 0.f); v0[j] = a * a; v1[j] = b * b; } }
                    u32x4 w; w.x = cvt_pk_bf16(v0[0], v0[1]); w.y = cvt_pk_bf16(v0[2], v0[3]); w.z = cvt_pk_bf16(v1[0], v1[1]); w.w = cvt_pk_bf16(v1[2], v1[3]);
                    *(u32x4*)(rowp + bj * HALF) = w; } }
    }
};
struct EpiRes {
    static constexpr bool PERM = false, AFTER_DRAIN = false;
    float* C; int ldc; const float* bias; const float* res; const float* gate; int gate_pitch; int panels_per_batch; float alpha;
    __device__ __forceinline__ void operator()(const f32x4 (&acc)[2][2][4][2], const Unit& u, int wr, int wc, int fr, int fq) const {
        const int row0 = u.pm * BM + wr * 64 + fr, col0 = u.pn * BM + wc * 32 + 4 * fq;
        const float* gp = gate + (size_t)(u.pm / panels_per_batch) * gate_pitch;
        f32x4 bv[2][2], gv[2][2];
#pragma unroll
        for (int bj = 0; bj < 2; ++bj)
#pragma unroll
            for (int n = 0; n < 2; ++n) { bv[bj][n] = bias ? *(const f32x4*)(bias + col0 + bj * HALF + n * 16) : (f32x4){0.f, 0.f, 0.f, 0.f};
                gv[bj][n] = *(const f32x4*)(gp + col0 + bj * HALF + n * 16) + 1.0f; }
#pragma unroll
        for (int ai = 0; ai < 2; ++ai)
#pragma unroll
            for (int m = 0; m < 4; ++m) { const size_t off = (size_t)(row0 + ai * HALF + m * 16) * ldc + col0;
#pragma unroll
                for (int bj = 0; bj < 2; ++bj)
#pragma unroll
                    for (int n = 0; n < 2; ++n) { const f32x4 r = *(const f32x4*)(res + off + bj * HALF + n * 16);
                        *(f32x4*)(C + off + bj * HALF + n * 16) = r * alpha + gv[bj][n] * (acc[ai][bj][m][n] + bv[bj][n]); }
                asm volatile("" ::: "memory"); }
    }
};

template <class Epi, class Sched, bool ALIGN_EPI = false, bool SP2 = false>
__device__ __forceinline__ void gemm_phase(PG8_LAS unsigned char* lds, const Gemm g, const Sched& S, const Epi& E) {
    int tid = threadIdx.x; asm volatile("" : "+v"(tid));
    const int wid = __builtin_amdgcn_readfirstlane(tid >> 6), lane = tid & 63, wr = wid >> 2, wc = wid & 3, fr = lane & 15, fq = lane >> 4;
    const int K = g.K, nt = K / BK;
    unsigned voffA[2], voffB[2];
#pragma unroll
    for (int i = 0; i < 2; ++i) { int R, C; stage_rc(tid * 16 + i * 8192, R, C); const int Rb = Epi::PERM ? ((R & ~31) + perm32(R & 31)) : R;
        voffA[i] = (unsigned)(R * K + C) * 2u; voffB[i] = (unsigned)(Rb * K + C) * 2u; }
    const size_t kstep = (size_t)(BK * 2);
    const size_t hstep = (size_t)HALF * K * 2;
    const size_t tstep = 2 * hstep;
    const unsigned ldsw = (unsigned)wid * 1024u;
    const int aoff = lds_byte(wr * 64 + fr, fq * 8), boff = lds_byte(wc * 32 + fr, fq * 8);
#define PG8_SA(b, h) (((b) * 2 + (h)) * HTB)
#define PG8_SB(b, h) ((4 + (b) * 2 + (h)) * HTB)
#define PG8_STAGE(bufoff, gbase, voff) do { _Pragma("unroll") for (int _i = 0; _i < 2; ++_i) \
        __builtin_amdgcn_global_load_lds((const unsigned*)((const char*)(gbase) + (voff)[_i]), (PG8_LAS unsigned*)(lds + (bufoff) + ldsw + _i * 8192), 16, 0, 0); } while (0)
#define PG8_LDA(dst, b, h) do { _Pragma("unroll") for (int m = 0; m < 4; ++m) _Pragma("unroll") for (int k = 0; k < 2; ++k) dst[m][k] = *(const PG8_LAS bf16x8*)(lds + PG8_SA(b, h) + aoff + m * 2048 + k * 1024); } while (0)
#define PG8_LDB(dst, b, h) do { _Pragma("unroll") for (int n = 0; n < 2; ++n) _Pragma("unroll") for (int k = 0; k < 2; ++k) dst[n][k] = *(const PG8_LAS bf16x8*)(lds + PG8_SB(b, h) + boff + n * 2048 + k * 1024); } while (0)
#define PG8_MMA(ai, bj, At, Bt) do { __builtin_amdgcn_s_setprio(1); _Pragma("unroll") for (int m = 0; m < 4; ++m) _Pragma("unroll") for (int n = 0; n < 2; ++n) _Pragma("unroll") for (int k = 0; k < 2; ++k) \
        acc[ai][bj][m][n] = __builtin_amdgcn_mfma_f32_16x16x32_bf16(Bt[n][k], At[m][k], acc[ai][bj][m][n], 0, 0, 0); __builtin_amdgcn_s_setprio(0); } while (0)
#define PG8_WAIT_V(n) asm volatile("s_waitcnt vmcnt(" #n ")" ::: "memory")
#define PG8_WAIT_L(n) asm volatile("s_waitcnt lgkmcnt(" #n ")" ::: "memory")
#define PG8_BAR __builtin_amdgcn_s_barrier()
#define PG8_SCHED __builtin_amdgcn_sched_barrier(0)
    Unit cur, nxt; int ui = 0;
    if (!S.next(0, cur)) return;
    f32x4 acc[2][2][4][2];
#pragma unroll
    for (int a = 0; a < 2; ++a)
#pragma unroll
        for (int b = 0; b < 2; ++b)
#pragma unroll
            for (int m = 0; m < 4; ++m)
#pragma unroll
                for (int n = 0; n < 2; ++n) acc[a][b][m][n] = (f32x4){0.f, 0.f, 0.f, 0.f};
    bf16x8 At[4][2], B0[2][2], B1[2][2];
    const char* cA = (const char*)g.A + (size_t)cur.pm * tstep; const char* cB = (const char*)g.Bt + (size_t)cur.pn * tstep;
    S.a_ready(cur);
    if constexpr (SP2) {
        PG8_STAGE(PG8_SB(0, 0), cB, voffB); PG8_STAGE(PG8_SB(0, 1), cB + hstep, voffB); PG8_STAGE(PG8_SA(0, 0), cA, voffA); PG8_STAGE(PG8_SA(0, 1), cA + hstep, voffA);
        if (wr == 1) PG8_BAR;
        PG8_WAIT_V(2); PG8_BAR;
        PG8_STAGE(PG8_SB(1, 0), cB + kstep, voffB); PG8_STAGE(PG8_SA(1, 0), cA + kstep, voffA); PG8_STAGE(PG8_SB(1, 1), cB + hstep + kstep, voffB);
        PG8_WAIT_V(6); PG8_BAR;
    } else {
        PG8_STAGE(PG8_SB(0, 0), cB, voffB); PG8_STAGE(PG8_SA(0, 0), cA, voffA); PG8_STAGE(PG8_SB(0, 1), cB + hstep, voffB); PG8_STAGE(PG8_SA(0, 1), cA + hstep, voffA);
        if (wr == 1) PG8_BAR;
        PG8_WAIT_V(4); PG8_BAR;
        PG8_STAGE(PG8_SB(1, 0), cB + kstep, voffB); PG8_STAGE(PG8_SA(1, 0), cA + kstep, voffA); PG8_STAGE(PG8_SB(1, 1), cB + hstep + kstep, voffB);
        PG8_WAIT_V(6); PG8_BAR;
    }
    for (;;) {
        const bool has_next = S.next(ui + 1, nxt);
        const char* nA = has_next ? (const char*)g.A + (size_t)nxt.pm * tstep : cA; const char* nB = has_next ? (const char*)g.Bt + (size_t)nxt.pn * tstep : cB;
        for (int t = 0; t < nt; t += 2) {
            const bool last = (t == nt - 2);
            const char* a1 = cA + (size_t)(t + 1) * kstep;
            const char* a2 = last ? nA : cA + (size_t)(t + 2) * kstep; const char* b2 = last ? nB : cB + (size_t)(t + 2) * kstep;
            const char* a3 = a2 + kstep; const char* b3 = b2 + kstep;
            if (last && has_next) S.a_ready(nxt);
            if constexpr (SP2) {
            PG8_LDB(B0, 0, 0); PG8_LDB(B1, 0, 1); PG8_SCHED; PG8_LDA(At, 0, 0); PG8_STAGE(PG8_SA(1, 1), a1 + hstep, voffA);
            PG8_WAIT_V(8); PG8_WAIT_L(0); PG8_BAR; PG8_MMA(0, 0, At, B0); PG8_MMA(0, 1, At, B1); PG8_BAR; PG8_SCHED;
            PG8_LDA(At, 0, 1); PG8_STAGE(PG8_SB(0, 0), b2, voffB); PG8_STAGE(PG8_SB(0, 1), b2 + hstep, voffB); PG8_STAGE(PG8_SA(0, 0), a2, voffA);
            PG8_WAIT_V(8); PG8_WAIT_L(0); PG8_BAR; PG8_MMA(1, 0, At, B0); PG8_MMA(1, 1, At, B1); PG8_BAR; PG8_SCHED;
            PG8_LDB(B0, 1, 0); PG8_LDB(B1, 1, 1); PG8_SCHED; PG8_LDA(At, 1, 0); PG8_STAGE(PG8_SA(0, 1), a2 + hstep, voffA);
            PG8_WAIT_V(8); PG8_WAIT_L(0); PG8_BAR; PG8_MMA(0, 0, At, B0); PG8_MMA(0, 1, At, B1); PG8_BAR; PG8_SCHED;
            PG8_LDA(At, 1, 1); PG8_STAGE(PG8_SB(1, 0), b3, voffB); PG8_STAGE(PG8_SB(1, 1), b3 + hstep, voffB); PG8_STAGE(PG8_SA(1, 0), a3, voffA);
            PG8_WAIT_V(8); PG8_WAIT_L(0); PG8_BAR; PG8_MMA(1, 0, At, B0); PG8_MMA(1, 1, At, B1); PG8_BAR; PG8_SCHED;
            } else {
            PG8_LDB(B0, 0, 0); PG8_SCHED; PG8_LDA(At, 0, 0); PG8_STAGE(PG8_SA(1, 1), a1 + hstep, voffA);
            PG8_WAIT_L(8); PG8_BAR; PG8_WAIT_L(0); PG8_MMA(0, 0, At, B0); PG8_BAR; PG8_SCHED;
            PG8_LDB(B1, 0, 1); PG8_STAGE(PG8_SB(0, 0), b2, voffB);
            PG8_BAR; PG8_WAIT_L(0); PG8_MMA(0, 1, At, B1); PG8_BAR;
            PG8_LDA(At, 0, 1); PG8_STAGE(PG8_SA(0, 0), a2, voffA);
            PG8_BAR; PG8_WAIT_L(0); PG8_MMA(1, 0, At, B0); PG8_BAR; PG8_SCHED;
            PG8_STAGE(PG8_SB(0, 1), b2 + hstep, voffB);
            PG8_WAIT_V(6); PG8_BAR; PG8_MMA(1, 1, At, B1); PG8_BAR;
            PG8_LDB(B0, 1, 0); PG8_SCHED; PG8_LDA(At, 1, 0); PG8_STAGE(PG8_SA(0, 1), a2 + hstep, voffA);
            PG8_WAIT_L(8); PG8_BAR; PG8_WAIT_L(0); PG8_MMA(0, 0, At, B0); PG8_BAR; PG8_SCHED;
            PG8_LDB(B1, 1, 1); PG8_STAGE(PG8_SB(1, 0), b3, voffB);
            PG8_BAR; PG8_WAIT_L(0); PG8_MMA(0, 1, At, B1); PG8_BAR;
            PG8_LDA(At, 1, 1); PG8_STAGE(PG8_SA(1, 0), a3, voffA);
            PG8_BAR; PG8_WAIT_L(0); PG8_MMA(1, 0, At, B0); PG8_BAR; PG8_SCHED;
            PG8_STAGE(PG8_SB(1, 1), b3 + hstep, voffB);
            PG8_WAIT_V(6); PG8_BAR; PG8_MMA(1, 1, At, B1); PG8_BAR;
            }
        }
        if constexpr (ALIGN_EPI) { if (wr == 0) PG8_BAR; }
        if constexpr (!Epi::AFTER_DRAIN) { E(acc, cur, wr, wc, fr, fq); S.done(cur); }
        if (!has_next) break;
#pragma unroll
        for (int a = 0; a < 2; ++a)
#pragma unroll
            for (int b = 0; b < 2; ++b)
#pragma unroll
                for (int m = 0; m < 4; ++m)
#pragma unroll
                    for (int n = 0; n < 2; ++n) acc[a][b][m][n] = (f32x4){0.f, 0.f, 0.f, 0.f};
        cur = nxt; cA = nA; cB = nB; ++ui;
        if constexpr (ALIGN_EPI) { if (wr == 1) PG8_BAR; }
    }
    PG8_WAIT_V(0);
    if constexpr (!ALIGN_EPI) { if (wr == 0) PG8_BAR; }
    PG8_BAR;
    if constexpr (Epi::AFTER_DRAIN) { E.fused(acc, cur, wr, wc, fr, fq, lds, wid, lane); S.done(cur); }
#undef PG8_SA
#undef PG8_SB
#undef PG8_STAGE
#undef PG8_LDA
#undef PG8_LDB
#undef PG8_MMA
#undef PG8_WAIT_V
#undef PG8_WAIT_L
#undef PG8_BAR
#undef PG8_SCHED
}
}

constexpr int NWAVES = 8;
constexpr int BATCH = 4, SEQ = 4096, D = 2048, DEPTH = 4;
constexpr int M = BATCH * SEQ;
constexpr int D_RG = 1024, RG_BW = 128;
constexpr int GLA_H = 4, GLA_DK = 512, GLA_DV = 1024, HK = 128, HV = 256, GLA_RANK = 16, CHUNK = 64, NCHUNK = SEQ / CHUNK;
constexpr int D_IN = 5136, NP = 5120;
constexpr int FF = 8192, NMOD = 6 * D;
constexpr int C_RGX = 0, C_RGG = 1024, C_Q = 2048, C_K = 2560, C_V = 3072, C_R = 4096, C_GLR = 5120;
constexpr float ALPHA = 1.6817928305074290f;
constexpr float LN_EPS = 1e-5f;
constexpr float RG_C = 8.0f, GLA_TAU = 16.0f;
constexpr float QSCALE = 0.08838834764831845f;

constexpr size_t MiB = 1u << 20;
constexpr size_t WS_CTL = 0, CTL_ZERO_BYTES = 1 * MiB;
constexpr size_t WS_MOD = 1 * MiB;
constexpr size_t WS_GLR = 2 * MiB;
constexpr size_t WS_W = 8 * MiB, W_LAYER = 93 * MiB;
constexpr size_t WO_IN = 0, WO_OUT = 20 * MiB, WO_UP = 28 * MiB, WO_DOWN = 60 * MiB, WO_GLR = 92 * MiB;
constexpr size_t WS_P = 384 * MiB;
constexpr size_t WS_CONCAT = 544 * MiB;
constexpr size_t WS_U = 608 * MiB;
constexpr size_t WS_V = 672 * MiB;
constexpr size_t WS_X1 = 800 * MiB;
constexpr size_t WS_HDN = 928 * MiB;
constexpr size_t WS_END = 1184 * MiB;
static_assert(WS_W + DEPTH * W_LAYER <= WS_P, "weights fit");
constexpr size_t WS_S = WS_U;
constexpr size_t S_XC = WS_S, S_A = WS_S + 64 * MiB, S_UU = WS_S + 128 * MiB, S_G = WS_S + 192 * MiB, S_ATT = WS_S + 224 * MiB, S_O = WS_S + 240 * MiB,
                 S_QD = WS_S + 304 * MiB, S_KI = WS_S + 336 * MiB, S_KT = WS_S + 368 * MiB, S_UPD = WS_S + 400 * MiB;
static_assert(S_UPD + 128 * MiB <= WS_END, "scratch fits");
constexpr int CW_TMO = 0, CW_CODE = 1, CW_BAR = 4096;

constexpr int RING_OFF = 0, RING_BYTES = 131072;
constexpr int LDSCTL_OFF = RING_BYTES, MISC_OFF = LDSCTL_OFF + 320;
constexpr int LDS_BYTES = 147456;
static_assert(MISC_OFF + 128 <= LDS_BYTES, "LDS map");
#define GAS __attribute__((address_space(1)))
#define LAS __attribute__((address_space(3)))
typedef unsigned short bf16;
typedef unsigned v4u __attribute__((ext_vector_type(4)));
typedef float f32x4 __attribute__((ext_vector_type(4)));
typedef short bf16x8 __attribute__((ext_vector_type(8)));
typedef GAS unsigned gu32;
typedef GAS unsigned long long gu64;
#define RLX_AGENT __ATOMIC_RELAXED, __HIP_MEMORY_SCOPE_AGENT
#define LDS_WAIT() asm volatile("s_waitcnt lgkmcnt(0)" ::: "memory")
#define VM_WAIT() asm volatile("s_waitcnt vmcnt(0)" ::: "memory")
__device__ __forceinline__ unsigned long long rt() { return __builtin_amdgcn_s_memrealtime(); }
__device__ __forceinline__ unsigned f2bf(float f) { unsigned u = __builtin_bit_cast(unsigned, f); return (u + 0x7fffu + ((u >> 16) & 1u)) >> 16; }
__device__ __forceinline__ unsigned pk2(float lo, float hi) { return f2bf(lo) | (f2bf(hi) << 16); }

#define XB_TMO      128
#define XB_XCNT(j)  (256  + 64 * (j))
#define XB_XSUB(j)  (1280 + 64 * (j))
#define XB_XGEN(j)  (2304 + 64 * (j))
#define XB_TOP      3328
#define XB_TOPGEN   3392
#define XCD_BAR_WORDS 3456
#define XB_SPIN_CAP (1u << 18)

__device__ __forceinline__ unsigned xb_ld(unsigned* p)              { return __hip_atomic_load(p, __ATOMIC_RELAXED, __HIP_MEMORY_SCOPE_AGENT); }
__device__ __forceinline__ unsigned xb_add(unsigned* p, unsigned v) { return __hip_atomic_fetch_add(p, v, __ATOMIC_RELAXED, __HIP_MEMORY_SCOPE_AGENT); }
__device__ __forceinline__ unsigned xb_xcc_id() { return (unsigned)__builtin_amdgcn_s_getreg((3 << 11) | 20) & 0xFu; }
#define XB_SPIN(cond, bar) do { unsigned _sp = 0; while (cond) { __builtin_amdgcn_s_sleep(1); \
    if ((++_sp & 255u) == 0u) { if (xb_ld(&(bar)[XB_TMO])) break; if (_sp > XB_SPIN_CAP) { atomicAdd(&(bar)[XB_TMO], 1u); break; } } } } while (0)

struct XcdBarrier {
    unsigned* bar; unsigned x;
    volatile LAS unsigned* st;
};

__device__ __forceinline__ XcdBarrier xcd_barrier_post(unsigned* bar, volatile LAS unsigned* st) {
    XcdBarrier b; b.bar = bar; b.x = xb_xcc_id(); b.st = st;
    if (threadIdx.x == 0) (void)xb_add(&bar[XB_XCNT(b.x)], 1u);
    return b;
}
__device__ __forceinline__ void xcd_barrier_complete(unsigned* bar, unsigned x, unsigned& nloc, unsigned& nx) {
    const unsigned G = gridDim.x * gridDim.y * gridDim.z;
    unsigned sum, cnt, mine, sp = 0u;
    for (;;) {
        sum = 0u; cnt = 0u; mine = 0u;
#pragma unroll
        for (unsigned j = 0; j < 16; ++j) { const unsigned c = xb_ld(&bar[XB_XCNT(j)]); sum += c; cnt += (c > 0u) ? 1u : 0u; mine = (j == x) ? c : mine; }
        if (sum == G) break;
        __builtin_amdgcn_s_sleep(1);
        if ((++sp & 255u) == 0u) { if (xb_ld(&bar[XB_TMO])) break; if (sp > XB_SPIN_CAP) { atomicAdd(&bar[XB_TMO], 1u); break; } }
    }
    nloc = mine > 0u ? mine : 1u; nx = cnt > 0u ? cnt : 1u;
}

__device__ __forceinline__ void xcd_barrier(const XcdBarrier& b) {
    asm volatile("s_waitcnt vmcnt(0)" ::: "memory");
    __syncthreads();
    if (threadIdx.x == 0) {
        unsigned* bar = b.bar; unsigned bxid = b.x; asm volatile("" : "+s"(bar), "+s"(bxid));
        __builtin_amdgcn_s_waitcnt(0);
        unsigned nloc = b.st[0], nx = b.st[1];
        if (nloc == 0u) { unsigned xx = bxid; asm volatile("" : "+s"(xx));   xcd_barrier_complete(bar, xx, nloc, nx); b.st[0] = nloc; b.st[1] = nx; }
        const unsigned old = xb_add(&bar[XB_XSUB(bxid)], 1u);
        const unsigned gen = old / nloc;
        if (old + 1u == (gen + 1u) * nloc) {
            __builtin_amdgcn_fence(__ATOMIC_RELEASE, "agent");
            asm volatile("s_waitcnt vmcnt(0)" ::: "memory");
            const unsigned og = xb_add(&bar[XB_TOP], 1u);
            const unsigned tg = og / nx;
            if (og + 1u == (tg + 1u) * nx) xb_add(&bar[XB_TOPGEN], 1u);
            else XB_SPIN(xb_ld(&bar[XB_TOPGEN]) == tg, bar);
            __builtin_amdgcn_fence(__ATOMIC_ACQUIRE, "agent");
            xb_add(&bar[XB_XGEN(bxid)], 1u);
            asm volatile("s_waitcnt vmcnt(0)" ::: "memory");
        } else {
            XB_SPIN(xb_ld(&bar[XB_XGEN(bxid)]) == gen, bar);
            __builtin_amdgcn_fence(__ATOMIC_ACQUIRE, "agent");
            asm volatile("s_waitcnt vmcnt(0)" ::: "memory");
        }
    }
    __syncthreads();
}


__device__ __forceinline__ float bf2f(bf16 b) { return __uint_as_float(((unsigned)b) << 16); }
__device__ __forceinline__ float wave_sum(float v) {
#pragma unroll
    for (int o = 1; o < 64; o <<= 1) v += __shfl_xor(v, o);
    return v;
}
__device__ __forceinline__ float sigmoidf_(float x) { return 1.0f / (1.0f + expf(-x)); }
__device__ __forceinline__ float softplusf_(float x) { return fmaxf(x, 0.f) + log1pf(expf(-fabsf(x))); }
__device__ __forceinline__ float gelu_tanh_(float x) { return 0.5f * x * (1.0f + tanhf(0.7978845608028654f * (x + 0.044715f * x * x * x))); }
__device__ __forceinline__ float siluf_(float x) { return x / (1.0f + expf(-x)); }

__device__ __forceinline__ void p0_transpose_item(const float* W, int K, int N, bf16* WT, LAS float* scr, int item, int lane) {
    const int nblk = N / 32, kb = item / nblk, nb = item % nblk, k0 = 64 * kb, n0 = 32 * nb;
#pragma unroll 8
    for (int i = 0; i < 32; ++i) { const int kk = 2 * i + (lane >> 5); scr[kk * 33 + (lane & 31)] = W[(size_t)(k0 + kk) * N + n0 + (lane & 31)]; }
    LDS_WAIT(); asm volatile("" ::: "memory");
    const int c = lane & 7;
#pragma unroll
    for (int j = 0; j < 4; ++j) { const int n = (lane >> 3) + 8 * j; const LAS float* s = scr + (8 * c) * 33 + n;
        v4u o; o.x = pk2(s[0 * 33], s[1 * 33]); o.y = pk2(s[2 * 33], s[3 * 33]); o.z = pk2(s[4 * 33], s[5 * 33]); o.w = pk2(s[6 * 33], s[7 * 33]);
        *(GAS v4u*)(WT + (size_t)(n0 + n) * K + k0 + 8 * c) = o; }
    LDS_WAIT(); asm volatile("" ::: "memory");
}

__device__ __forceinline__ void mod_phase(const float* c, const float* w_ada, const float* b_ada, float* MOD, LAS unsigned char* lds, int vcu, int G, int tid) {
    LAS float* cact = (LAS float*)lds;
    LAS float* red = (LAS float*)(lds + 32768);
    for (int i = tid; i < BATCH * D; i += 512) { const float x = c[i]; cact[i] = x / (1.0f + expf(-x)); }
    __syncthreads();
    const int wave = tid >> 6, lane = tid & 63;
    constexpr int NBLK = NMOD / 256;
    for (int unit = vcu; unit < DEPTH * NBLK; unit += G) {
        const int l = unit / NBLK, nb = unit % NBLK;
        const float* wp = w_ada + (size_t)l * D * NMOD + (size_t)(wave * 256) * NMOD + nb * 256 + lane * 4;
        f32x4 acc[4];
#pragma unroll
        for (int b = 0; b < 4; ++b) acc[b] = (f32x4){0.f, 0.f, 0.f, 0.f};
#pragma unroll 8
        for (int k = 0; k < 256; ++k) {
            const f32x4 w = *(const GAS f32x4*)(wp + (size_t)k * NMOD);
#pragma unroll
            for (int b = 0; b < 4; ++b) acc[b] += w * cact[b * D + wave * 256 + k];
        }
#pragma unroll
        for (int b = 0; b < 4; ++b) *(LAS f32x4*)(red + (wave * 4 + b) * 256 + lane * 4) = acc[b];
        __syncthreads();
        for (int o = tid; o < 4 * 256; o += 512) { const int b = o >> 8, n = o & 255; float s = b_ada[(size_t)l * NMOD + nb * 256 + n];
#pragma unroll
            for (int w = 0; w < 8; ++w) s += red[(w * 4 + b) * 256 + n];
            MOD[((size_t)l * BATCH + b) * NMOD + nb * 256 + n] = s; }
        __syncthreads();
    }
}

__device__ __forceinline__ void modulate_rows(const float* x, const float* sh, const float* sc, bf16* U, int gw, int NGW, int lane) {
    for (int m = gw; m < M; m += NGW) {
        const int b = m / SEQ; const GAS f32x4* xr = (const GAS f32x4*)(x + (size_t)m * D) + lane;
        const GAS f32x4* shp = (const GAS f32x4*)(sh + (size_t)b * NMOD) + lane; const GAS f32x4* scp = (const GAS f32x4*)(sc + (size_t)b * NMOD) + lane;
        GAS unsigned long long* o8 = (GAS unsigned long long*)(U + (size_t)m * D) + lane;
#pragma unroll
        for (int j = 0; j < 8; ++j) { const f32x4 v = xr[64 * j], s = scp[64 * j], h = shp[64 * j]; const f32x4 u = v * (s + 1.0f) + h;
            o8[64 * j] = (unsigned long long)pk2(u.x, u.y) | ((unsigned long long)pk2(u.z, u.w) << 32); }
    }
}
__device__ __forceinline__ void ln_rows(const float* V, const float* g, const float* bta, float* Xo, const float* sh, const float* sc, bf16* U, int gw, int NGW, int lane) {
    for (int m = gw; m < M; m += NGW) {
        const GAS f32x4* vr = (const GAS f32x4*)(V + (size_t)m * D) + lane;
        f32x4 v[8]; float s = 0.f;
#pragma unroll
        for (int j = 0; j < 8; ++j) { v[j] = vr[64 * j]; s += (v[j].x + v[j].y) + (v[j].z + v[j].w); }
        const float mean = wave_sum(s) * (1.f / D); float s2 = 0.f;
#pragma unroll
        for (int j = 0; j < 8; ++j) { v[j] = v[j] - mean; s2 += (v[j].x * v[j].x + v[j].y * v[j].y) + (v[j].z * v[j].z + v[j].w * v[j].w); }
        const float rstd = 1.f / sqrtf(wave_sum(s2) * (1.f / D) + LN_EPS);
        GAS f32x4* xo = (GAS f32x4*)(Xo + (size_t)m * D) + lane;
        const GAS f32x4* gp = (const GAS f32x4*)g + lane; const GAS f32x4* bp = (const GAS f32x4*)bta + lane;
#pragma unroll
        for (int j = 0; j < 8; ++j) { v[j] = v[j] * rstd * gp[64 * j] + bp[64 * j]; xo[64 * j] = v[j]; }
        if (U) { const int b = m / SEQ;
            const GAS f32x4* shp = (const GAS f32x4*)(sh + (size_t)b * NMOD) + lane; const GAS f32x4* scp = (const GAS f32x4*)(sc + (size_t)b * NMOD) + lane;
            GAS unsigned long long* o8 = (GAS unsigned long long*)(U + (size_t)m * D) + lane;
#pragma unroll
            for (int j = 0; j < 8; ++j) { const f32x4 u = v[j] * (scp[64 * j] + 1.0f) + shp[64 * j];
                o8[64 * j] = (unsigned long long)pk2(u.x, u.y) | ((unsigned long long)pk2(u.z, u.w) << 32); } }
    }
}
__device__ __forceinline__ void glr_rows(const bf16* U, const bf16* Wg, float* GLR, int gw, int NGW, int lane) {
    for (int m = gw; m < M; m += NGW) {
        const GAS v4u* ur = (const GAS v4u*)(U + (size_t)m * D) + lane;
        float uf[32];
#pragma unroll
        for (int j = 0; j < 4; ++j) { const v4u q = ur[64 * j];
            uf[8 * j + 0] = __uint_as_float(q.x << 16); uf[8 * j + 1] = __uint_as_float(q.x & 0xffff0000u); uf[8 * j + 2] = __uint_as_float(q.y << 16); uf[8 * j + 3] = __uint_as_float(q.y & 0xffff0000u);
            uf[8 * j + 4] = __uint_as_float(q.z << 16); uf[8 * j + 5] = __uint_as_float(q.z & 0xffff0000u); uf[8 * j + 6] = __uint_as_float(q.w << 16); uf[8 * j + 7] = __uint_as_float(q.w & 0xffff0000u); }
        float myout = 0.f;
#pragma unroll 1
        for (int r = 0; r < GLA_RANK; ++r) {
            const GAS v4u* wr_ = (const GAS v4u*)(Wg + (size_t)r * D) + lane; float s = 0.f;
#pragma unroll
            for (int j = 0; j < 4; ++j) { const v4u q = wr_[64 * j];
                s += uf[8 * j + 0] * __uint_as_float(q.x << 16) + uf[8 * j + 1] * __uint_as_float(q.x & 0xffff0000u) + uf[8 * j + 2] * __uint_as_float(q.y << 16) + uf[8 * j + 3] * __uint_as_float(q.y & 0xffff0000u)
                   + uf[8 * j + 4] * __uint_as_float(q.z << 16) + uf[8 * j + 5] * __uint_as_float(q.z & 0xffff0000u) + uf[8 * j + 6] * __uint_as_float(q.w << 16) + uf[8 * j + 7] * __uint_as_float(q.w & 0xffff0000u); }
            s = wave_sum(s); if (lane == r) myout = s;
        }
        if (lane < GLA_RANK) GLR[(size_t)m * GLA_RANK + lane] = myout;
    }
}

__device__ __forceinline__ void n_conv(const bf16* P, const float* cw, const float* cb, float* XC, size_t gt, size_t NT) {
    for (size_t idx = gt; idx < (size_t)M * D_RG; idx += NT) { const int m = (int)(idx / D_RG), c = (int)(idx % D_RG), t = m % SEQ; float acc = cb[c];
#pragma unroll
        for (int j = 0; j < 4; ++j) { const int tt = t - 3 + j; if (tt >= 0) acc += cw[j * D_RG + c] * bf2f(P[(size_t)(m - 3 + j) * NP + C_RGX + c]); }
        XC[idx] = acc; }
}
__device__ __forceinline__ void n_gates(const float* XC, const float* wa, const float* ba, const float* wx, const float* bx, const float* lam, float* A, float* UU, size_t gt, size_t NT) {
    for (size_t idx = gt; idx < (size_t)M * D_RG; idx += NT) { const int m = (int)(idx / D_RG), c = (int)(idx % D_RG), h = c >> 7, j = c & 127;
        const float* xr = XC + (size_t)m * D_RG + h * RG_BW; const float* wap = wa + (size_t)h * RG_BW * RG_BW + j; const float* wxp = wx + (size_t)h * RG_BW * RG_BW + j;
        float ga = ba[c], gx = bx[c];
        for (int i = 0; i < RG_BW; ++i) { const float xv = xr[i]; ga += xv * wap[i * RG_BW]; gx += xv * wxp[i * RG_BW]; }
        const float r = sigmoidf_(ga), ig = sigmoidf_(gx), la = -RG_C * r * softplusf_(-lam[c]);
        A[idx] = expf(la); UU[idx] = sqrtf(-expm1f(2.0f * la)) * ig * XC[idx]; }
}
__device__ __forceinline__ void n_rgscan(const float* A, float* UU, size_t gt) {
    if (gt < (size_t)BATCH * D_RG) { const int b = (int)(gt / D_RG), c = (int)(gt % D_RG); float h = 0.f; size_t o = (size_t)b * SEQ * D_RG + c;
#pragma unroll 16
        for (int t = 0; t < SEQ; ++t, o += D_RG) { h = A[o] * h + UU[o]; UU[o] = h; } }
}
__device__ __forceinline__ void n_rgout(const float* H, const bf16* P, bf16* CC, size_t gt, size_t NT) {
    for (size_t idx = gt; idx < (size_t)M * D_RG; idx += NT) { const int m = (int)(idx / D_RG), c = (int)(idx % D_RG);
        CC[(size_t)m * D + c] = (bf16)f2bf(H[idx] * gelu_tanh_(bf2f(P[(size_t)m * NP + C_RGG + c]))); }
}
__device__ __forceinline__ void n_g(const float* GLR, const float* wg2, const float* bg2, float* Gb, size_t gt, size_t NT) {
    for (size_t idx = gt; idx < (size_t)M * GLA_DK; idx += NT) { const int m = (int)(idx / GLA_DK), d = (int)(idx % GLA_DK); float z = bg2[d];
#pragma unroll
        for (int r = 0; r < GLA_RANK; ++r) z += GLR[(size_t)m * GLA_RANK + r] * wg2[r * GLA_DK + d];
        Gb[idx] = -softplusf_(-z) * (1.0f / GLA_TAU); }
}
__device__ __forceinline__ void n_bcum(float* Gb, size_t gt, size_t NT) {
    for (size_t idx = gt; idx < (size_t)(M / CHUNK) * GLA_DK; idx += NT) { const int cn = (int)(idx / GLA_DK), d = (int)(idx % GLA_DK); float s = 0.f; size_t o = (size_t)cn * CHUNK * GLA_DK + d;
        for (int j = 0; j < CHUNK; ++j, o += GLA_DK) { s += Gb[o]; Gb[o] = s; } }
}
__device__ __forceinline__ void n_qk(const bf16* P, const float* Gb, float* QD, float* KI, float* KT, size_t gt, size_t NT) {
    for (size_t idx = gt; idx < (size_t)M * GLA_DK; idx += NT) { const int m = (int)(idx / GLA_DK), d = (int)(idx % GLA_DK), cn = m / CHUNK;
        const float bc = Gb[idx], bl = Gb[(size_t)(cn * CHUNK + CHUNK - 1) * GLA_DK + d];
        const float q = bf2f(P[(size_t)m * NP + C_Q + d]), k = bf2f(P[(size_t)m * NP + C_K + d]);
        QD[idx] = q * QSCALE * expf(bc); KI[idx] = k * expf(-bc); KT[idx] = k * expf(bl - bc); }
}
__device__ __forceinline__ void n_upd(const bf16* P, const float* KT, float* UPD, size_t gt, size_t NT) {
    for (size_t idx = gt; idx < (size_t)(M / CHUNK) * GLA_H * HK * HV; idx += NT) { const int v = (int)(idx % HV), d = (int)((idx / HV) % HK), h = (int)((idx / (HV * HK)) % GLA_H), cn = (int)(idx / ((size_t)HV * HK * GLA_H));
        float acc = 0.f; const size_t m0 = (size_t)cn * CHUNK;
        for (int j = 0; j < CHUNK; ++j) acc += KT[(m0 + j) * GLA_DK + h * HK + d] * bf2f(P[(m0 + j) * NP + C_V + h * HV + v]);
        UPD[idx] = acc; }
}
__device__ __forceinline__ void n_sscan(const float* Gb, float* UPD, size_t gt, size_t NT) {
    for (size_t idx = gt; idx < (size_t)BATCH * GLA_H * HK * HV; idx += NT) { const int v = (int)(idx % HV), d = (int)((idx / HV) % HK), h = (int)((idx / (HV * HK)) % GLA_H), b = (int)(idx / ((size_t)HV * HK * GLA_H));
        float s = 0.f;
        for (int n = 0; n < NCHUNK; ++n) { const int cn = b * NCHUNK + n; const size_t o = (((size_t)cn * GLA_H + h) * HK + d) * HV + v;
            const float u = UPD[o]; UPD[o] = s; const float dec = expf(Gb[(size_t)(cn * CHUNK + CHUNK - 1) * GLA_DK + h * HK + d]); s = dec * s + u; } }
}
__device__ __forceinline__ void n_att(const float* QD, const float* KI, float* ATT, size_t gt, size_t NT) {
    for (size_t idx = gt; idx < (size_t)(M / CHUNK) * GLA_H * CHUNK * CHUNK; idx += NT) { const int j = (int)(idx % CHUNK), i = (int)((idx / CHUNK) % CHUNK), h = (int)((idx / (CHUNK * CHUNK)) % GLA_H), cn = (int)(idx / ((size_t)CHUNK * CHUNK * GLA_H));
        float acc = 0.f;
        if (j <= i) { const float* qp = QD + (size_t)(cn * CHUNK + i) * GLA_DK + h * HK; const float* kp = KI + (size_t)(cn * CHUNK + j) * GLA_DK + h * HK;
            for (int d = 0; d < HK; ++d) acc += qp[d] * kp[d]; }
        ATT[idx] = acc; }
}
__device__ __forceinline__ void n_o(const bf16* P, const float* QD, const float* SP, const float* ATT, float* O, size_t gt, size_t NT) {
    for (size_t idx = gt; idx < (size_t)M * GLA_DV; idx += NT) { const int m = (int)(idx / GLA_DV), hv = (int)(idx % GLA_DV), h = hv / HV, v = hv % HV, cn = m / CHUNK, i = m % CHUNK;
        float acc = 0.f; const float* qp = QD + (size_t)m * GLA_DK + h * HK; const float* sp = SP + (((size_t)cn * GLA_H + h) * HK) * HV + v;
        for (int d = 0; d < HK; ++d) acc += qp[d] * sp[(size_t)d * HV];
        const float* ap = ATT + (((size_t)cn * GLA_H + h) * CHUNK + i) * CHUNK;
        for (int j = 0; j <= i; ++j) acc += ap[j] * bf2f(P[(size_t)(cn * CHUNK + j) * NP + C_V + hv]);
        O[idx] = acc; }
}
__device__ __forceinline__ void n_norm(const float* O, const bf16* P, const float* ng, bf16* CC, int gw, int NGW, int lane) {
    for (int it = gw; it < M * GLA_H; it += NGW) { const int m = it / GLA_H, h = it % GLA_H; const float* op = O + (size_t)m * GLA_DV + h * HV;
        float o[4]; float ss = 0.f;
#pragma unroll
        for (int j = 0; j < 4; ++j) { o[j] = op[lane + 64 * j]; ss += o[j] * o[j]; }
        const float rs = 1.0f / sqrtf(wave_sum(ss) * (1.0f / HV) + LN_EPS);
#pragma unroll
        for (int j = 0; j < 4; ++j) { const int hv = h * HV + lane + 64 * j; const float r = bf2f(P[(size_t)m * NP + C_R + hv]);
            CC[(size_t)m * D + D_RG + hv] = (bf16)f2bf(o[j] * rs * ng[hv] * siluf_(r)); } }
}

struct Args { const float* in[24]; float* out; unsigned char* ws; int ph_lo, ph_hi; };
typedef const __attribute__((address_space(4))) unsigned char* kargp_t;
__device__ __forceinline__ const float* karg_in(int i) { kargp_t ka = (kargp_t)__builtin_amdgcn_kernarg_segment_ptr(); asm volatile("" : "+s"(ka)); return *(const float* const __attribute__((address_space(4)))*)(ka + 8 * i); }
__device__ __forceinline__ float* karg_out() { kargp_t ka = (kargp_t)__builtin_amdgcn_kernarg_segment_ptr(); asm volatile("" : "+s"(ka)); return *(float* const __attribute__((address_space(4)))*)(ka + 8 * 24); }
__device__ __forceinline__ unsigned char* karg_ws() { kargp_t ka = (kargp_t)__builtin_amdgcn_kernarg_segment_ptr(); asm volatile("" : "+s"(ka)); return *(unsigned char* const __attribute__((address_space(4)))*)(ka + 8 * 25); }
#define IN(i) karg_in(i)
__global__ void __launch_bounds__(NWAVES * 64, 2) mk_fwd(Args args) {
    extern __shared__ __attribute__((aligned(16))) unsigned char lds[];
    LAS unsigned char* const L0 = (LAS unsigned char*)lds;
    volatile LAS unsigned* const MISC = (volatile LAS unsigned*)(L0 + MISC_OFF);
    const int G0 = gridDim.x; const int bx0 = blockIdx.x; const int vcu0 = (G0 % 8 == 0) ? (bx0 % 8) * (G0 / 8) + bx0 / 8 : bx0;
    for (int u = threadIdx.x; u < (LDS_BYTES - LDSCTL_OFF) / 4; u += NWAVES * 64) ((LAS unsigned*)(L0 + LDSCTL_OFF))[u] = 0u;
    __syncthreads();
    XcdBarrier bar; bar.bar = (unsigned*)(karg_ws() + WS_CTL) + CW_BAR; bar.x = 0; bar.st = nullptr;
    if (!MK_LAUNCH_PER_PHASE) bar = xcd_barrier_post((unsigned*)(karg_ws() + WS_CTL) + CW_BAR, MISC + 8);
#if MK_LAUNCH_PER_PHASE
    const int lo = args.ph_lo, hi = args.ph_hi; int pid = 0;
#define PH_ON() (pid >= lo && pid < hi)
#define PH_END() do { ++pid; } while (0)
#else
    (void)args;
#define PH_ON() true
#define PH_END() xcd_barrier(bar)
#endif
#define PH_LOCALS() int tid = threadIdx.x; asm volatile("" : "+v"(tid)); const int lane = tid & 63, wave = __builtin_amdgcn_readfirstlane(tid >> 6); \
    int G = G0, bx = bx0, vcu = vcu0; asm volatile("" : "+s"(G), "+s"(bx), "+s"(vcu)); LAS unsigned char* L = L0; asm volatile("" : "+s"(L)); \
    unsigned char* const ws = karg_ws(); const int gw = vcu * NWAVES + wave, NGW = G * NWAVES; \
    const size_t gt = (size_t)vcu * (NWAVES * 64) + tid, NT = (size_t)G * (NWAVES * 64); \
    float* const MOD = (float*)(ws + WS_MOD); float* const GLR = (float*)(ws + WS_GLR); \
    bf16* const P = (bf16*)(ws + WS_P); bf16* const CC = (bf16*)(ws + WS_CONCAT); bf16* const U = (bf16*)(ws + WS_U); \
    float* const V = (float*)(ws + WS_V); float* const X1 = (float*)(ws + WS_X1); bf16* const HDN = (bf16*)(ws + WS_HDN); \
    (void)L; (void)bx; (void)lane; (void)wave; (void)gw; (void)NGW; (void)gt; (void)NT; (void)MOD; (void)GLR; (void)P; (void)CC; (void)U; (void)V; (void)X1; (void)HDN;

    if (PH_ON()) { PH_LOCALS();
        LAS float* scr = (LAS float*)(L + RING_OFF + wave * 16384);
        constexpr int I_IN = (D / 64) * (NP / 32), I_OUT = (D / 64) * (D / 32), I_UP = (D / 64) * (FF / 32), I_DOWN = (FF / 64) * (D / 32), I_L = I_IN + I_OUT + I_UP + I_DOWN;
        for (int it = gw; it < DEPTH * I_L; it += NGW) {
            const int l = it / I_L; int r = it % I_L; unsigned char* wl = ws + WS_W + (size_t)l * W_LAYER;
            if (r < I_IN) { p0_transpose_item(IN(4) + (size_t)l * D * D_IN, D, D_IN, (bf16*)(wl + WO_IN), scr, r, lane); continue; } r -= I_IN;
            if (r < I_OUT) { p0_transpose_item(IN(15) + (size_t)l * D * D, D, D, (bf16*)(wl + WO_OUT), scr, r, lane); continue; } r -= I_OUT;
            if (r < I_UP) { p0_transpose_item(IN(18) + (size_t)l * D * FF, D, FF, (bf16*)(wl + WO_UP), scr, r, lane); continue; } r -= I_UP;
            p0_transpose_item(IN(20) + (size_t)l * FF * D, FF, D, (bf16*)(wl + WO_DOWN), scr, r, lane);
        }
        { const float* w_in = IN(4);
        for (size_t i = gt; i < (size_t)DEPTH * GLA_RANK * D; i += NT) { const int l = (int)(i / (GLA_RANK * D)), j = (int)((i / D) % GLA_RANK), k = (int)(i % D);
            ((bf16*)(ws + WS_W + (size_t)l * W_LAYER + WO_GLR))[j * D + k] = (bf16)f2bf(w_in[(size_t)l * D * D_IN + (size_t)k * D_IN + C_GLR + j]); } }
        __syncthreads();
        mod_phase(IN(1), IN(2), IN(3), MOD, L, vcu, G, tid);
    }
    PH_END();
    if (PH_ON()) { PH_LOCALS(); modulate_rows(IN(0), MOD + 0 * D, MOD + 1 * D, U, gw, NGW, lane); }
    PH_END();

    for (int l = 0; l < DEPTH; ++l) {
#define WL() (ws + WS_W + (size_t)l * W_LAYER)
#define MODL() (MOD + (size_t)l * BATCH * NMOD)
        if (PH_ON()) { PH_LOCALS();
            pg8::Gemm g{U, (const bf16*)(WL() + WO_IN), M, NP, D}; pg8::StaticOrder S; S.init(M, NP, G, bx);
            pg8::EpiBf16<0> E{P, NP, nullptr};
            pg8::gemm_phase<pg8::EpiBf16<0>, pg8::StaticOrder, true, true>(L + RING_OFF, g, S, E);
            glr_rows(U, (const bf16*)(WL() + WO_GLR), GLR, gw, NGW, lane);
        }
        PH_END();
#define SCRATCH_PTRS() float* XC = (float*)(ws + S_XC); float* A = (float*)(ws + S_A); float* UU = (float*)(ws + S_UU); float* Gb = (float*)(ws + S_G); float* ATT = (float*)(ws + S_ATT); \
            float* O = (float*)(ws + S_O); float* QD = (float*)(ws + S_QD); float* KI = (float*)(ws + S_KI); float* KT = (float*)(ws + S_KT); float* UPD = (float*)(ws + S_UPD); \
            (void)XC; (void)A; (void)UU; (void)Gb; (void)ATT; (void)O; (void)QD; (void)KI; (void)KT; (void)UPD;
        if (PH_ON()) { PH_LOCALS(); SCRATCH_PTRS(); n_conv(P, IN(5) + (size_t)l * 4 * D_RG, IN(6) + (size_t)l * D_RG, XC, gt, NT);
                       n_g(GLR, IN(12) + (size_t)l * GLA_RANK * GLA_DK, IN(13) + (size_t)l * GLA_DK, Gb, gt, NT); }
        PH_END();
        if (PH_ON()) { PH_LOCALS(); SCRATCH_PTRS(); n_gates(XC, IN(7) + (size_t)l * D_RG * RG_BW, IN(8) + (size_t)l * D_RG, IN(9) + (size_t)l * D_RG * RG_BW, IN(10) + (size_t)l * D_RG, IN(11) + (size_t)l * D_RG, A, UU, gt, NT);
                       n_bcum(Gb, gt, NT); }
        PH_END();
        if (PH_ON()) { PH_LOCALS(); SCRATCH_PTRS(); n_rgscan(A, UU, gt); n_qk(P, Gb, QD, KI, KT, gt, NT); }
        PH_END();
        if (PH_ON()) { PH_LOCALS(); SCRATCH_PTRS(); n_rgout(UU, P, CC, gt, NT); n_upd(P, KT, UPD, gt, NT); n_att(QD, KI, ATT, gt, NT); }
        PH_END();
        if (PH_ON()) { PH_LOCALS(); SCRATCH_PTRS(); n_sscan(Gb, UPD, gt, NT); }
        PH_END();
        if (PH_ON()) { PH_LOCALS(); SCRATCH_PTRS(); n_o(P, QD, UPD, ATT, O, gt, NT); }
        PH_END();
        if (PH_ON()) { PH_LOCALS(); SCRATCH_PTRS(); n_norm(O, P, IN(14) + (size_t)l * GLA_DV, CC, gw, NGW, lane); }
        PH_END();
        if (PH_ON()) { PH_LOCALS();
            const float* const xprev = (l == 0) ? IN(0) : karg_out();
            pg8::Gemm g{CC, (const bf16*)(WL() + WO_OUT), M, D, D}; pg8::StaticOrder S; S.init(M, D, G, bx);
            pg8::EpiRes E{V, D, nullptr, xprev, MODL() + 2 * D, NMOD, SEQ / 256, ALPHA};
            pg8::gemm_phase<pg8::EpiRes, pg8::StaticOrder, true, true>(L + RING_OFF, g, S, E);
        }
        PH_END();
        if (PH_ON()) { PH_LOCALS(); ln_rows(V, IN(16) + (size_t)l * D, IN(17) + (size_t)l * D, X1, MODL() + 3 * D, MODL() + 4 * D, U, gw, NGW, lane); }
        PH_END();
        if (PH_ON()) { PH_LOCALS();
            pg8::Gemm g{U, (const bf16*)(WL() + WO_UP), M, FF, D}; pg8::StaticOrder S; S.init(M, FF, G, bx);
            pg8::EpiBf16<3> E{HDN, FF, IN(19) + (size_t)l * FF};
            pg8::gemm_phase<pg8::EpiBf16<3>, pg8::StaticOrder, true, true>(L + RING_OFF, g, S, E);
        }
        PH_END();
        if (PH_ON()) { PH_LOCALS();
            pg8::Gemm g{HDN, (const bf16*)(WL() + WO_DOWN), M, D, FF}; pg8::StaticOrder S; S.init(M, D, G, bx);
            pg8::EpiRes E{V, D, IN(21) + (size_t)l * D, X1, MODL() + 5 * D, NMOD, SEQ / 256, ALPHA};
            pg8::gemm_phase<pg8::EpiRes, pg8::StaticOrder, true, true>(L + RING_OFF, g, S, E);
        }
        PH_END();
        if (PH_ON()) { PH_LOCALS();
            const bool more = (l + 1 < DEPTH); const float* modn = MOD + (size_t)(more ? l + 1 : l) * BATCH * NMOD;
            ln_rows(V, IN(22) + (size_t)l * D, IN(23) + (size_t)l * D, karg_out(), modn + 0 * D, modn + 1 * D, more ? U : (bf16*)nullptr, gw, NGW, lane);
        }
        PH_END();
    }
    if (!MK_LAUNCH_PER_PHASE) {
        if (bx0 == 0 && threadIdx.x == 0 && __hip_atomic_load((gu32*)((unsigned*)(karg_ws() + WS_CTL) + CW_BAR + XB_TMO), RLX_AGENT) != 0u) karg_out()[0] = __builtin_nanf("");
    }
#undef PH_ON
#undef PH_END
}
constexpr int N_PHASES = 2 + DEPTH * 13;

extern "C" void kernel_launch(void* const* d_in, const int* in_sizes, int n_in, void* d_out, int out_size, void* d_ws, size_t ws_size, hipStream_t stream) {
    static int grid = 0;
    if (grid == 0) {
        if (n_in != 24 || in_sizes[0] != M * D || out_size != M * D || ws_size < WS_END) { fprintf(stderr, "kernel_launch: unexpected shapes / workspace: n_in %d in0 %d out %d ws %zu (need %zu)\n", n_in, n_in > 0 ? in_sizes[0] : -1, out_size, ws_size, (size_t)WS_END); grid = -1; return; }
        int dev = 0, cus = 0, per_cu = 0;
        if (hipGetDevice(&dev) != hipSuccess || hipDeviceGetAttribute(&cus, hipDeviceAttributeMultiprocessorCount, dev) != hipSuccess) { fprintf(stderr, "kernel_launch: device query failed\n"); grid = -1; return; }
        if (hipFuncSetAttribute((const void*)mk_fwd, hipFuncAttributeMaxDynamicSharedMemorySize, LDS_BYTES) != hipSuccess) { fprintf(stderr, "kernel_launch: hipFuncSetAttribute failed\n"); grid = -1; return; }
        if (hipOccupancyMaxActiveBlocksPerMultiprocessor(&per_cu, (const void*)mk_fwd, NWAVES * 64, LDS_BYTES) != hipSuccess || per_cu < 1)
            fprintf(stderr, "kernel_launch: note: occupancy query reports %d workgroups per CU\n", per_cu);
        (void)hipGetLastError();
        grid = cus;
    }
    if (grid < 0) return;
    if (hipMemsetAsync((char*)d_ws + WS_CTL, 0, CTL_ZERO_BYTES, stream) != hipSuccess) { fprintf(stderr, "kernel_launch: memset failed\n"); return; }
    Args a{};
    for (int i = 0; i < 24; ++i) a.in[i] = (const float*)d_in[i];
    a.out = (float*)d_out; a.ws = (unsigned char*)d_ws;
#if MK_LAUNCH_PER_PHASE
    for (int p = 0; p < N_PHASES; ++p) { a.ph_lo = p; a.ph_hi = p + 1; hipLaunchKernelGGL(mk_fwd, dim3(grid), dim3(NWAVES * 64), LDS_BYTES, stream, a); }
#else
    a.ph_lo = 0; a.ph_hi = N_PHASES;
    hipLaunchKernelGGL(mk_fwd, dim3(grid), dim3(NWAVES * 64), LDS_BYTES, stream, a);
#endif
    const hipError_t le = hipPeekAtLastError();
    if (le != hipSuccess) fprintf(stderr, "kernel_launch: launch failed: %s\n", hipGetErrorName(le));
}
```

```cpp
#include <hip/hip_runtime.h>
#include <cstdio>
#include <cstdint>
#ifndef MK_LAUNCH_PER_PHASE
#define MK_LAUNCH_PER_PHASE 0
#endif
namespace pg8 {
#define PG8_LAS __attribute__((address_space(3)))
typedef unsigned short bf16_t;
typedef short bf16x8 __attribute__((ext_vector_type(8)));
typedef float f32x4 __attribute__((ext_vector_type(4)));
typedef unsigned u32x4 __attribute__((ext_vector_type(4)));
constexpr int BM = 256, BK = 64, HALF = 128, HTB = HALF * BK * 2  , STAGE_BYTES = 8 * HTB, NXCD = 8, WGM = 8;

__host__ __device__ __forceinline__ int lds_byte(int r, int c) { const int st = (r >> 4) * 2 + (c >> 5), rr = r & 15, cc = c & 31, ob = rr * 64 + cc * 2; return st * 1024 + (ob ^ (((ob >> 9) & 1) << 5)); }
__host__ __device__ __forceinline__ void stage_rc(int b, int& R, int& C) { const int st = b / 1024, sb = b % 1024, swz = sb ^ (((sb >> 9) & 1) << 5); R = (st >> 1) * 16 + swz / 64; C = (st & 1) * 32 + (swz % 64) / 2; }
__host__ __device__ __forceinline__ int perm32(int rho) { const int n = rho >> 4, i = rho & 15; return 8 * (i >> 2) + 4 * n + (i & 3); }

struct Unit { int pm, pn; };
struct Gemm { const bf16_t* A; const bf16_t* Bt; int M, N, K; };

struct StaticOrder {
    int nM, nN, nwg, G, c;
    __host__ __device__ void init(int M, int N, int G_, int c_) { nM = M / BM; nN = N / BM; nwg = nM * nN; G = G_; c = c_; }
    __host__ __device__ bool next(int i, Unit& u) const {
        const long L = (long)i * G + c; if (L >= nwg) return false;
        int wgid = (int)L; { const int q = nwg / NXCD, r = nwg % NXCD, xcd = wgid % NXCD, off = wgid / NXCD; wgid = (xcd < r ? xcd * (q + 1) : r * (q + 1) + (xcd - r) * q) + off; }
        const int nig = WGM * nN, gid = wgid / nig, fm = gid * WGM, gsz = (nM - fm) < WGM ? (nM - fm) : WGM;
        u.pm = fm + ((wgid % nig) % gsz); u.pn = (wgid % nig) / gsz; return true;
    }
    __device__ __forceinline__ void a_ready(const Unit&) const {}
    __device__ __forceinline__ void done(const Unit&) const {}
};

__device__ __forceinline__ unsigned cvt_pk_bf16(float lo, float hi) { unsigned r; asm volatile("v_cvt_pk_bf16_f32 %0, %1, %2" : "=v"(r) : "v"(lo), "v"(hi)); return r; }
typedef float f32x2 __attribute__((ext_vector_type(2)));

template <int ACT> struct EpiBf16 {
    static constexpr bool PERM = true, AFTER_DRAIN = false;
    bf16_t* O; int ldc; const float* bias;
    __device__ __forceinline__ void operator()(const f32x4 (&acc)[2][2][4][2], const Unit& u, int wr, int wc, int fr, int fq) const {
        const int row0 = u.pm * BM + wr * 64 + fr; const int colt = u.pn * BM; bf16_t* base = O;
        const int col0 = colt + wc * 32 + 8 * fq;
        f32x4 bv[2][2];
#pragma unroll
        for (int bj = 0; bj < 2; ++bj)
#pragma unroll
            for (int n = 0; n < 2; ++n) bv[bj][n] = bias ? *(const f32x4*)(bias + col0 + bj * HALF + 4 * n) : (f32x4){0.f, 0.f, 0.f, 0.f};
#pragma unroll
        for (int ai = 0; ai < 2; ++ai)
#pragma unroll
            for (int m = 0; m < 4; ++m) { bf16_t* rowp = base + (size_t)(row0 + ai * HALF + m * 16) * ldc + col0;
#pragma unroll
                for (int bj = 0; bj < 2; ++bj) { f32x4 v0 = acc[ai][bj][m][0] + bv[bj][0], v1 = acc[ai][bj][m][1] + bv[bj][1];
                    if (ACT == 3) {
#pragma unroll
                        for (int j = 0; j < 4; ++j) { const float a = fmaxf(v0[j], 0.f), b = fmaxf(v1[j], 0.f); v0[j] = a * a; v1[j] = b * b; } }
                    u32x4 w; w.x = cvt_pk_bf16(v0[0], v0[1]); w.y = cvt_pk_bf16(v0[2], v0[3]); w.z = cvt_pk_bf16(v1[0], v1[1]); w.w = cvt_pk_bf16(v1[2], v1[3]);
                    *(u32x4*)(rowp + bj * HALF) = w; } }
    }
};
struct EpiRes {
    static constexpr bool PERM = false, AFTER_DRAIN = false;
    float* C; int ldc; const float* bias; const float* res; const float* gate; int gate_pitch; int panels_per_batch; float alpha;
    __device__ __forceinline__ void operator()(const f32x4 (&acc)[2][2][4][2], const Unit& u, int wr, int wc, int fr, int fq) const {
        const int row0 = u.pm * BM + wr * 64 + fr, col0 = u.pn * BM + wc * 32 + 4 * fq;
        const float* gp = gate + (size_t)(u.pm / panels_per_batch) * gate_pitch;
        f32x4 bv[2][2], gv[2][2];
#pragma unroll
        for (int bj = 0; bj < 2; ++bj)
#pragma unroll
            for (int n = 0; n < 2; ++n) { bv[bj][n] = bias ? *(const f32x4*)(bias + col0 + bj * HALF + n * 16) : (f32x4){0.f, 0.f, 0.f, 0.f};
                gv[bj][n] = *(const f32x4*)(gp + col0 + bj * HALF + n * 16) + 1.0f; }
#pragma unroll
        for (int ai = 0; ai < 2; ++ai)
#pragma unroll
            for (int m = 0; m < 4; ++m) { const size_t off = (size_t)(row0 + ai * HALF + m * 16) * ldc + col0;
#pragma unroll
                for (int bj = 0; bj < 2; ++bj)
#pragma unroll
                    for (int n = 0; n < 2; ++n) { const f32x4 r = *(const f32x4*)(res + off + bj * HALF + n * 16);
                        *(f32x4*)(C + off + bj * HALF + n * 16) = r * alpha + gv[bj][n] * (acc[ai][bj][m][n] + bv[bj][n]); }
                asm volatile("" ::: "memory"); }
    }
};

template <class Epi, class Sched, bool ALIGN_EPI = false, bool SP2 = false>
__device__ __forceinline__ void gemm_phase(PG8_LAS unsigned char* lds, int tid_in, const Gemm g, const Sched& S, const Epi& E) {
    int tid = tid_in; asm volatile("" : "+v"(tid));
    const int wid = __builtin_amdgcn_readfirstlane(tid >> 6), lane = tid & 63, wr = wid >> 2, wc = wid & 3, fr = lane & 15, fq = lane >> 4;
    const int K = g.K, nt = K / BK;
    unsigned voffA[2], voffB[2];
#pragma unroll
    for (int i = 0; i < 2; ++i) { int R, C; stage_rc(tid * 16 + i * 8192, R, C); const int Rb = Epi::PERM ? ((R & ~31) + perm32(R & 31)) : R;
        voffA[i] = (unsigned)(R * K + C) * 2u; voffB[i] = (unsigned)(Rb * K + C) * 2u; }
    const size_t kstep = (size_t)(BK * 2);
    const size_t hstep = (size_t)HALF * K * 2;
    const size_t tstep = 2 * hstep;
    const unsigned ldsw = (unsigned)wid * 1024u;
    const int aoff = lds_byte(wr * 64 + fr, fq * 8), boff = lds_byte(wc * 32 + fr, fq * 8);
#define PG8_SA(b, h) (((b) * 2 + (h)) * HTB)
#define PG8_SB(b, h) ((4 + (b) * 2 + (h)) * HTB)
#define PG8_STAGE(bufoff, gbase, voff) do { _Pragma("unroll") for (int _i = 0; _i < 2; ++_i) \
        __builtin_amdgcn_global_load_lds((const unsigned*)((const char*)(gbase) + (voff)[_i]), (PG8_LAS unsigned*)(lds + (bufoff) + ldsw + _i * 8192), 16, 0, 0); } while (0)
#define PG8_LDA(dst, b, h) do { _Pragma("unroll") for (int m = 0; m < 4; ++m) _Pragma("unroll") for (int k = 0; k < 2; ++k) dst[m][k] = *(const PG8_LAS bf16x8*)(lds + PG8_SA(b, h) + aoff + m * 2048 + k * 1024); } while (0)
#define PG8_LDB(dst, b, h) do { _Pragma("unroll") for (int n = 0; n < 2; ++n) _Pragma("unroll") for (int k = 0; k < 2; ++k) dst[n][k] = *(const PG8_LAS bf16x8*)(lds + PG8_SB(b, h) + boff + n * 2048 + k * 1024); } while (0)
#define PG8_MMA(ai, bj, At, Bt) do { __builtin_amdgcn_s_setprio(1); _Pragma("unroll") for (int m = 0; m < 4; ++m) _Pragma("unroll") for (int n = 0; n < 2; ++n) _Pragma("unroll") for (int k = 0; k < 2; ++k) \
        acc[ai][bj][m][n] = __builtin_amdgcn_mfma_f32_16x16x32_bf16(Bt[n][k], At[m][k], acc[ai][bj][m][n], 0, 0, 0); __builtin_amdgcn_s_setprio(0); } while (0)
#define PG8_WAIT_V(n) asm volatile("s_waitcnt vmcnt(" #n ")" ::: "memory")
#define PG8_WAIT_L(n) asm volatile("s_waitcnt lgkmcnt(" #n ")" ::: "memory")
#define PG8_BAR __builtin_amdgcn_s_barrier()
#define PG8_SCHED __builtin_amdgcn_sched_barrier(0)
    Unit cur, nxt; int ui = 0;
    if (!S.next(0, cur)) return;
    f32x4 acc[2][2][4][2];
#pragma unroll
    for (int a = 0; a < 2; ++a)
#pragma unroll
        for (int b = 0; b < 2; ++b)
#pragma unroll
            for (int m = 0; m < 4; ++m)
#pragma unroll
                for (int n = 0; n < 2; ++n) acc[a][b][m][n] = (f32x4){0.f, 0.f, 0.f, 0.f};
    bf16x8 At[4][2], B0[2][2], B1[2][2];
    const char* cA = (const char*)g.A + (size_t)cur.pm * tstep; const char* cB = (const char*)g.Bt + (size_t)cur.pn * tstep;
    S.a_ready(cur);
    if constexpr (SP2) {
        PG8_STAGE(PG8_SB(0, 0), cB, voffB); PG8_STAGE(PG8_SB(0, 1), cB + hstep, voffB); PG8_STAGE(PG8_SA(0, 0), cA, voffA); PG8_STAGE(PG8_SA(0, 1), cA + hstep, voffA);
        if (wr == 1) PG8_BAR;
        PG8_WAIT_V(2); PG8_BAR;
        PG8_STAGE(PG8_SB(1, 0), cB + kstep, voffB); PG8_STAGE(PG8_SA(1, 0), cA + kstep, voffA); PG8_STAGE(PG8_SB(1, 1), cB + hstep + kstep, voffB);
        PG8_WAIT_V(6); PG8_BAR;
    } else {
        PG8_STAGE(PG8_SB(0, 0), cB, voffB); PG8_STAGE(PG8_SA(0, 0), cA, voffA); PG8_STAGE(PG8_SB(0, 1), cB + hstep, voffB); PG8_STAGE(PG8_SA(0, 1), cA + hstep, voffA);
        if (wr == 1) PG8_BAR;
        PG8_WAIT_V(4); PG8_BAR;
        PG8_STAGE(PG8_SB(1, 0), cB + kstep, voffB); PG8_STAGE(PG8_SA(1, 0), cA + kstep, voffA); PG8_STAGE(PG8_SB(1, 1), cB + hstep + kstep, voffB);
        PG8_WAIT_V(6); PG8_BAR;
    }
    for (;;) {
        const bool has_next = S.next(ui + 1, nxt);
        const char* nA = has_next ? (const char*)g.A + (size_t)nxt.pm * tstep : cA; const char* nB = has_next ? (const char*)g.Bt + (size_t)nxt.pn * tstep : cB;
        for (int t = 0; t < nt; t += 2) {
            const bool last = (t == nt - 2);
            const char* a1 = cA + (size_t)(t + 1) * kstep;
            const char* a2 = last ? nA : cA + (size_t)(t + 2) * kstep; const char* b2 = last ? nB : cB + (size_t)(t + 2) * kstep;
            const char* a3 = a2 + kstep; const char* b3 = b2 + kstep;
            if (last && has_next) S.a_ready(nxt);
            if constexpr (SP2) {
            PG8_LDB(B0, 0, 0); PG8_LDB(B1, 0, 1); PG8_SCHED; PG8_LDA(At, 0, 0); PG8_STAGE(PG8_SA(1, 1), a1 + hstep, voffA);
            PG8_WAIT_V(8); PG8_WAIT_L(0); PG8_BAR; PG8_MMA(0, 0, At, B0); PG8_MMA(0, 1, At, B1); PG8_BAR; PG8_SCHED;
            PG8_LDA(At, 0, 1); PG8_STAGE(PG8_SB(0, 0), b2, voffB); PG8_STAGE(PG8_SB(0, 1), b2 + hstep, voffB); PG8_STAGE(PG8_SA(0, 0), a2, voffA);
            PG8_WAIT_V(8); PG8_WAIT_L(0); PG8_BAR; PG8_MMA(1, 0, At, B0); PG8_MMA(1, 1, At, B1); PG8_BAR; PG8_SCHED;
            PG8_LDB(B0, 1, 0); PG8_LDB(B1, 1, 1); PG8_SCHED; PG8_LDA(At, 1, 0); PG8_STAGE(PG8_SA(0, 1), a2 + hstep, voffA);
            PG8_WAIT_V(8); PG8_WAIT_L(0); PG8_BAR; PG8_MMA(0, 0, At, B0); PG8_MMA(0, 1, At, B1); PG8_BAR; PG8_SCHED;
            PG8_LDA(At, 1, 1); PG8_STAGE(PG8_SB(1, 0), b3, voffB); PG8_STAGE(PG8_SB(1, 1), b3 + hstep, voffB); PG8_STAGE(PG8_SA(1, 0), a3, voffA);
            PG8_WAIT_V(8); PG8_WAIT_L(0); PG8_BAR; PG8_MMA(1, 0, At, B0); PG8_MMA(1, 1, At, B1); PG8_BAR; PG8_SCHED;
            } else {
            PG8_LDB(B0, 0, 0); PG8_SCHED; PG8_LDA(At, 0, 0); PG8_STAGE(PG8_SA(1, 1), a1 + hstep, voffA);
            PG8_WAIT_L(8); PG8_BAR; PG8_WAIT_L(0); PG8_MMA(0, 0, At, B0); PG8_BAR; PG8_SCHED;
            PG8_LDB(B1, 0, 1); PG8_STAGE(PG8_SB(0, 0), b2, voffB);
            PG8_BAR; PG8_WAIT_L(0); PG8_MMA(0, 1, At, B1); PG8_BAR;
            PG8_LDA(At, 0, 1); PG8_STAGE(PG8_SA(0, 0), a2, voffA);
            PG8_BAR; PG8_WAIT_L(0); PG8_MMA(1, 0, At, B0); PG8_BAR; PG8_SCHED;
            PG8_STAGE(PG8_SB(0, 1), b2 + hstep, voffB);
            PG8_WAIT_V(6); PG8_BAR; PG8_MMA(1, 1, At, B1); PG8_BAR;
            PG8_LDB(B0, 1, 0); PG8_SCHED; PG8_LDA(At, 1, 0); PG8_STAGE(PG8_SA(0, 1), a2 + hstep, voffA);
            PG8_WAIT_L(8); PG8_BAR; PG8_WAIT_L(0); PG8_MMA(0, 0, At, B0); PG8_BAR; PG8_SCHED;
            PG8_LDB(B1, 1, 1); PG8_STAGE(PG8_SB(1, 0), b3, voffB);
            PG8_BAR; PG8_WAIT_L(0); PG8_MMA(0, 1, At, B1); PG8_BAR;
            PG8_LDA(At, 1, 1); PG8_STAGE(PG8_SA(1, 0), a3, voffA);
            PG8_BAR; PG8_WAIT_L(0); PG8_MMA(1, 0, At, B0); PG8_BAR; PG8_SCHED;
            PG8_STAGE(PG8_SB(1, 1), b3 + hstep, voffB);
            PG8_WAIT_V(6); PG8_BAR; PG8_MMA(1, 1, At, B1); PG8_BAR;
            }
        }
        if constexpr (ALIGN_EPI) { if (wr == 0) PG8_BAR; }
        if constexpr (!Epi::AFTER_DRAIN) { E(acc, cur, wr, wc, fr, fq); S.done(cur); }
        if (!has_next) break;
#pragma unroll
        for (int a = 0; a < 2; ++a)
#pragma unroll
            for (int b = 0; b < 2; ++b)
#pragma unroll
                for (int m = 0; m < 4; ++m)
#pragma unroll
                    for (int n = 0; n < 2; ++n) acc[a][b][m][n] = (f32x4){0.f, 0.f, 0.f, 0.f};
        cur = nxt; cA = nA; cB = nB; ++ui;
        if constexpr (ALIGN_EPI) { if (wr == 1) PG8_BAR; }
    }
    PG8_WAIT_V(0);
    if constexpr (!ALIGN_EPI) { if (wr == 0) PG8_BAR; }
    PG8_BAR;
    if constexpr (Epi::AFTER_DRAIN) { E.fused(acc, cur, wr, wc, fr, fq, lds, wid, lane); S.done(cur); }
#undef PG8_SA
#undef PG8_SB
#undef PG8_STAGE
#undef PG8_LDA
#undef PG8_LDB
#undef PG8_MMA
#undef PG8_WAIT_V
#undef PG8_WAIT_L
#undef PG8_BAR
#undef PG8_SCHED
}
}

constexpr int NWAVES = 8;
constexpr int BATCH = 4, SEQ = 4096, D = 2048, DEPTH = 4;
constexpr int M = BATCH * SEQ;
constexpr int D_RG = 1024, RG_BW = 128;
constexpr int GLA_H = 4, GLA_DK = 512, GLA_DV = 1024, HK = 128, HV = 256, GLA_RANK = 16, CHUNK = 64, NCHUNK = SEQ / CHUNK;
constexpr int D_IN = 5136, NP = 5120;
constexpr int FF = 8192, NMOD = 6 * D;
constexpr int C_RGX = 0, C_RGG = 1024, C_Q = 2048, C_K = 2560, C_V = 3072, C_R = 4096, C_GLR = 5120;
constexpr float ALPHA = 1.6817928305074290f;
constexpr float LN_EPS = 1e-5f;
constexpr float RG_C = 8.0f, GLA_TAU = 16.0f;
constexpr float QSCALE = 0.08838834764831845f;

constexpr size_t MiB = 1u << 20;
constexpr size_t WS_CTL = 0, CTL_ZERO_BYTES = 1 * MiB;
constexpr size_t WS_MOD = 1 * MiB;
constexpr size_t WS_GLR = 2 * MiB;
constexpr size_t WS_DSEG = 4 * MiB;
constexpr size_t WS_SLOC = 672 * MiB;
constexpr size_t WS_RGAGG = 3 * MiB;
constexpr size_t WS_W = 8 * MiB, W_LAYER = 93 * MiB;
constexpr size_t WO_IN = 0, WO_OUT = 20 * MiB, WO_UP = 28 * MiB, WO_DOWN = 60 * MiB, WO_GLR = 92 * MiB;
constexpr size_t WS_P = 384 * MiB;
constexpr size_t WS_CONCAT = 544 * MiB;
constexpr size_t WS_U = 608 * MiB;
constexpr size_t WS_V = 672 * MiB;
constexpr size_t WS_X1 = 800 * MiB;
constexpr size_t WS_HDN = 928 * MiB;
constexpr size_t WS_END = 1184 * MiB;
static_assert(WS_W + DEPTH * W_LAYER <= WS_P, "weights fit");
constexpr size_t WS_S = WS_U;
constexpr size_t S_XC = WS_S, S_A = WS_S + 64 * MiB, S_UU = WS_S + 128 * MiB, S_G = WS_S + 192 * MiB, S_ATT = WS_S + 224 * MiB, S_O = WS_S + 240 * MiB,
                 S_QD = WS_S + 304 * MiB, S_KI = WS_S + 336 * MiB, S_KT = WS_S + 368 * MiB, S_UPD = WS_S + 400 * MiB;
static_assert(S_UPD + 128 * MiB <= WS_END, "scratch fits");
constexpr int CW_TMO = 0, CW_CODE = 1, CW_BAR = 4096;

constexpr int RING_OFF = 0, RING_BYTES = 131072;
constexpr int LDSCTL_OFF = 147456 - 512, MISC_OFF = LDSCTL_OFF + 320;
constexpr int LDS_BYTES = 147456;
static_assert(MISC_OFF + 128 <= LDS_BYTES, "LDS map");
#define GAS __attribute__((address_space(1)))
#define LAS __attribute__((address_space(3)))
typedef unsigned short bf16;
typedef unsigned v4u __attribute__((ext_vector_type(4)));
typedef float f32x4 __attribute__((ext_vector_type(4)));
typedef short bf16x8 __attribute__((ext_vector_type(8)));
typedef GAS unsigned gu32;
typedef GAS unsigned long long gu64;
#define RLX_AGENT __ATOMIC_RELAXED, __HIP_MEMORY_SCOPE_AGENT
#define LDS_WAIT() asm volatile("s_waitcnt lgkmcnt(0)" ::: "memory")
#define VM_WAIT() asm volatile("s_waitcnt vmcnt(0)" ::: "memory")
__device__ __forceinline__ unsigned long long rt() { return __builtin_amdgcn_s_memrealtime(); }
__device__ __forceinline__ unsigned f2bf(float f) { unsigned u = __builtin_bit_cast(unsigned, f); return (u + 0x7fffu + ((u >> 16) & 1u)) >> 16; }
__device__ __forceinline__ unsigned pk2(float lo, float hi) { return f2bf(lo) | (f2bf(hi) << 16); }

#define XB_TMO      128
#define XB_XCNT(j)  (256  + 64 * (j))
#define XB_XSUB(j)  (1280 + 64 * (j))
#define XB_XGEN(j)  (2304 + 64 * (j))
#define XB_TOP      3328
#define XB_TOPGEN   3392
#define XCD_BAR_WORDS 3456
#define XB_SPIN_CAP (1u << 18)

__device__ __forceinline__ unsigned xb_ld(unsigned* p)              { return __hip_atomic_load(p, __ATOMIC_RELAXED, __HIP_MEMORY_SCOPE_AGENT); }
__device__ __forceinline__ unsigned xb_add(unsigned* p, unsigned v) { return __hip_atomic_fetch_add(p, v, __ATOMIC_RELAXED, __HIP_MEMORY_SCOPE_AGENT); }
__device__ __forceinline__ unsigned xb_xcc_id() { return (unsigned)__builtin_amdgcn_s_getreg((3 << 11) | 20) & 0xFu; }
#define XB_SPIN(cond, bar) do { unsigned _sp = 0; while (cond) { __builtin_amdgcn_s_sleep(1); \
    if ((++_sp & 255u) == 0u) { if (xb_ld(&(bar)[XB_TMO])) break; if (_sp > XB_SPIN_CAP) { atomicAdd(&(bar)[XB_TMO], 1u); break; } } } } while (0)

struct XcdBarrier {
    unsigned* bar; unsigned x;
    volatile LAS unsigned* st;
};

__device__ __forceinline__ XcdBarrier xcd_barrier_post(unsigned* bar, volatile LAS unsigned* st, int tid) {
    XcdBarrier b; b.bar = bar; b.x = xb_xcc_id(); b.st = st;
    if (tid == 0) (void)xb_add(&bar[XB_XCNT(b.x)], 1u);
    return b;
}
__device__ __forceinline__ void xcd_barrier_complete(unsigned* bar, unsigned x, unsigned& nloc, unsigned& nx) {
    const unsigned G = gridDim.x * gridDim.y * gridDim.z;
    unsigned sum, cnt, mine, sp = 0u;
    for (;;) {
        sum = 0u; cnt = 0u; mine = 0u;
#pragma unroll
        for (unsigned j = 0; j < 16; ++j) { const unsigned c = xb_ld(&bar[XB_XCNT(j)]); sum += c; cnt += (c > 0u) ? 1u : 0u; mine = (j == x) ? c : mine; }
        if (sum == G) break;
        __builtin_amdgcn_s_sleep(1);
        if ((++sp & 255u) == 0u) { if (xb_ld(&bar[XB_TMO])) break; if (sp > XB_SPIN_CAP) { atomicAdd(&bar[XB_TMO], 1u); break; } }
    }
    nloc = mine > 0u ? mine : 1u; nx = cnt > 0u ? cnt : 1u;
}

__device__ __forceinline__ void xcd_barrier(const XcdBarrier& b, int tid) {
    asm volatile("s_waitcnt vmcnt(0)" ::: "memory");
    __syncthreads();
    if (tid == 0) {
        unsigned* bar = b.bar; unsigned bxid = b.x; asm volatile("" : "+s"(bar), "+s"(bxid));
        __builtin_amdgcn_s_waitcnt(0);
        unsigned nloc = b.st[0], nx = b.st[1];
        if (nloc == 0u) { unsigned xx = bxid; asm volatile("" : "+s"(xx));   xcd_barrier_complete(bar, xx, nloc, nx); b.st[0] = nloc; b.st[1] = nx; }
        const unsigned old = xb_add(&bar[XB_XSUB(bxid)], 1u);
        const unsigned gen = old / nloc;
        if (old + 1u == (gen + 1u) * nloc) {
            __builtin_amdgcn_fence(__ATOMIC_RELEASE, "agent");
            asm volatile("s_waitcnt vmcnt(0)" ::: "memory");
            const unsigned og = xb_add(&bar[XB_TOP], 1u);
            const unsigned tg = og / nx;
            if (og + 1u == (tg + 1u) * nx) xb_add(&bar[XB_TOPGEN], 1u);
            else XB_SPIN(xb_ld(&bar[XB_TOPGEN]) == tg, bar);
            __builtin_amdgcn_fence(__ATOMIC_ACQUIRE, "agent");
            xb_add(&bar[XB_XGEN(bxid)], 1u);
            asm volatile("s_waitcnt vmcnt(0)" ::: "memory");
        } else {
            XB_SPIN(xb_ld(&bar[XB_XGEN(bxid)]) == gen, bar);
            __builtin_amdgcn_fence(__ATOMIC_ACQUIRE, "agent");
            asm volatile("s_waitcnt vmcnt(0)" ::: "memory");
        }
    }
    __syncthreads();
}


__device__ __forceinline__ float bf2f(bf16 b) { return __uint_as_float(((unsigned)b) << 16); }
__device__ __forceinline__ float wave_sum(float v) {
#pragma unroll
    for (int o = 1; o < 64; o <<= 1) v += __shfl_xor(v, o);
    return v;
}
__device__ __forceinline__ float sigmoidf_(float x) { return 1.0f / (1.0f + expf(-x)); }
__device__ __forceinline__ float softplusf_(float x) { return fmaxf(x, 0.f) + log1pf(expf(-fabsf(x))); }
__device__ __forceinline__ float gelu_tanh_(float x) { return 0.5f * x * (1.0f + tanhf(0.7978845608028654f * (x + 0.044715f * x * x * x))); }
__device__ __forceinline__ float siluf_(float x) { return x / (1.0f + expf(-x)); }

__device__ __forceinline__ void p0_transpose_item(const float* W, int K, int N, bf16* WT, LAS float* scr, int item, int lane) {
    const int nblk = N / 32, kb = item / nblk, nb = item % nblk, k0 = 64 * kb, n0 = 32 * nb;
#pragma unroll 8
    for (int i = 0; i < 32; ++i) { const int kk = 2 * i + (lane >> 5); scr[kk * 33 + (lane & 31)] = W[(size_t)(k0 + kk) * N + n0 + (lane & 31)]; }
    LDS_WAIT(); asm volatile("" ::: "memory");
    const int c = lane & 7;
#pragma unroll
    for (int j = 0; j < 4; ++j) { const int n = (lane >> 3) + 8 * j; const LAS float* s = scr + (8 * c) * 33 + n;
        v4u o; o.x = pk2(s[0 * 33], s[1 * 33]); o.y = pk2(s[2 * 33], s[3 * 33]); o.z = pk2(s[4 * 33], s[5 * 33]); o.w = pk2(s[6 * 33], s[7 * 33]);
        *(GAS v4u*)(WT + (size_t)(n0 + n) * K + k0 + 8 * c) = o; }
    LDS_WAIT(); asm volatile("" ::: "memory");
}

__device__ __forceinline__ void mod_phase(const float* c, const float* w_ada, const float* b_ada, float* MOD, LAS unsigned char* lds, int vcu, int G, int tid) {
    LAS float* cact = (LAS float*)lds;
    LAS float* red = (LAS float*)(lds + 32768);
    for (int i = tid; i < BATCH * D; i += 512) { const float x = c[i]; cact[i] = x / (1.0f + expf(-x)); }
    __syncthreads();
    const int wave = tid >> 6, lane = tid & 63;
    constexpr int NBLK = NMOD / 256;
    for (int unit = vcu; unit < DEPTH * NBLK; unit += G) {
        const int l = unit / NBLK, nb = unit % NBLK;
        const float* wp = w_ada + (size_t)l * D * NMOD + (size_t)(wave * 256) * NMOD + nb * 256 + lane * 4;
        f32x4 acc[4];
#pragma unroll
        for (int b = 0; b < 4; ++b) acc[b] = (f32x4){0.f, 0.f, 0.f, 0.f};
#pragma unroll 8
        for (int k = 0; k < 256; ++k) {
            const f32x4 w = *(const GAS f32x4*)(wp + (size_t)k * NMOD);
#pragma unroll
            for (int b = 0; b < 4; ++b) acc[b] += w * cact[b * D + wave * 256 + k];
        }
#pragma unroll
        for (int b = 0; b < 4; ++b) *(LAS f32x4*)(red + (wave * 4 + b) * 256 + lane * 4) = acc[b];
        __syncthreads();
        for (int o = tid; o < 4 * 256; o += 512) { const int b = o >> 8, n = o & 255; float s = b_ada[(size_t)l * NMOD + nb * 256 + n];
#pragma unroll
            for (int w = 0; w < 8; ++w) s += red[(w * 4 + b) * 256 + n];
            MOD[((size_t)l * BATCH + b) * NMOD + nb * 256 + n] = s; }
        __syncthreads();
    }
}

__device__ __forceinline__ void modulate_rows(const float* x, const float* sh, const float* sc, bf16* U, int gw, int NGW, int lane) {
    for (int m = gw; m < M; m += NGW) {
        const int b = m / SEQ; const GAS f32x4* xr = (const GAS f32x4*)(x + (size_t)m * D) + lane;
        const GAS f32x4* shp = (const GAS f32x4*)(sh + (size_t)b * NMOD) + lane; const GAS f32x4* scp = (const GAS f32x4*)(sc + (size_t)b * NMOD) + lane;
        GAS unsigned long long* o8 = (GAS unsigned long long*)(U + (size_t)m * D) + lane;
#pragma unroll
        for (int j = 0; j < 8; ++j) { const f32x4 v = xr[64 * j], s = scp[64 * j], h = shp[64 * j]; const f32x4 u = v * (s + 1.0f) + h;
            o8[64 * j] = (unsigned long long)pk2(u.x, u.y) | ((unsigned long long)pk2(u.z, u.w) << 32); }
    }
}
__device__ __forceinline__ void ln_rows(const float* V, const float* g, const float* bta, float* Xo, const float* sh, const float* sc, bf16* U, int gw, int NGW, int lane) {
    for (int m = gw; m < M; m += NGW) {
        const GAS f32x4* vr = (const GAS f32x4*)(V + (size_t)m * D) + lane;
        f32x4 v[8]; float s = 0.f;
#pragma unroll
        for (int j = 0; j < 8; ++j) { v[j] = vr[64 * j]; s += (v[j].x + v[j].y) + (v[j].z + v[j].w); }
        const float mean = wave_sum(s) * (1.f / D); float s2 = 0.f;
#pragma unroll
        for (int j = 0; j < 8; ++j) { v[j] = v[j] - mean; s2 += (v[j].x * v[j].x + v[j].y * v[j].y) + (v[j].z * v[j].z + v[j].w * v[j].w); }
        const float rstd = 1.f / sqrtf(wave_sum(s2) * (1.f / D) + LN_EPS);
        GAS f32x4* xo = (GAS f32x4*)(Xo + (size_t)m * D) + lane;
        const GAS f32x4* gp = (const GAS f32x4*)g + lane; const GAS f32x4* bp = (const GAS f32x4*)bta + lane;
#pragma unroll
        for (int j = 0; j < 8; ++j) { v[j] = v[j] * rstd * gp[64 * j] + bp[64 * j]; xo[64 * j] = v[j]; }
        if (U) { const int b = m / SEQ;
            const GAS f32x4* shp = (const GAS f32x4*)(sh + (size_t)b * NMOD) + lane; const GAS f32x4* scp = (const GAS f32x4*)(sc + (size_t)b * NMOD) + lane;
            GAS unsigned long long* o8 = (GAS unsigned long long*)(U + (size_t)m * D) + lane;
#pragma unroll
            for (int j = 0; j < 8; ++j) { const f32x4 u = v[j] * (scp[64 * j] + 1.0f) + shp[64 * j];
                o8[64 * j] = (unsigned long long)pk2(u.x, u.y) | ((unsigned long long)pk2(u.z, u.w) << 32); } }
    }
}
__device__ __forceinline__ void glr_rows(const bf16* U, const bf16* Wg, float* GLR, int gw, int NGW, int lane) {
    for (int m = gw; m < M; m += NGW) {
        const GAS v4u* ur = (const GAS v4u*)(U + (size_t)m * D) + lane;
        float uf[32];
#pragma unroll
        for (int j = 0; j < 4; ++j) { const v4u q = ur[64 * j];
            uf[8 * j + 0] = __uint_as_float(q.x << 16); uf[8 * j + 1] = __uint_as_float(q.x & 0xffff0000u); uf[8 * j + 2] = __uint_as_float(q.y << 16); uf[8 * j + 3] = __uint_as_float(q.y & 0xffff0000u);
            uf[8 * j + 4] = __uint_as_float(q.z << 16); uf[8 * j + 5] = __uint_as_float(q.z & 0xffff0000u); uf[8 * j + 6] = __uint_as_float(q.w << 16); uf[8 * j + 7] = __uint_as_float(q.w & 0xffff0000u); }
        float myout = 0.f;
#pragma unroll 1
        for (int r = 0; r < GLA_RANK; ++r) {
            const GAS v4u* wr_ = (const GAS v4u*)(Wg + (size_t)r * D) + lane; float s = 0.f;
#pragma unroll
            for (int j = 0; j < 4; ++j) { const v4u q = wr_[64 * j];
                s += uf[8 * j + 0] * __uint_as_float(q.x << 16) + uf[8 * j + 1] * __uint_as_float(q.x & 0xffff0000u) + uf[8 * j + 2] * __uint_as_float(q.y << 16) + uf[8 * j + 3] * __uint_as_float(q.y & 0xffff0000u)
                   + uf[8 * j + 4] * __uint_as_float(q.z << 16) + uf[8 * j + 5] * __uint_as_float(q.z & 0xffff0000u) + uf[8 * j + 6] * __uint_as_float(q.w << 16) + uf[8 * j + 7] * __uint_as_float(q.w & 0xffff0000u); }
            s = wave_sum(s); if (lane == r) myout = s;
        }
        if (lane < GLA_RANK) GLR[(size_t)m * GLA_RANK + lane] = myout;
    }
}

typedef __bf16 bf16x2_t __attribute__((ext_vector_type(2)));
typedef float f32x2_t __attribute__((ext_vector_type(2)));
typedef float f32x16 __attribute__((ext_vector_type(16)));
typedef short s16x4 __attribute__((ext_vector_type(4)));
__device__ __forceinline__ unsigned cvtpk(float lo, float hi) { f32x2_t v = {lo, hi}; bf16x2_t b = __builtin_convertvector(v, bf16x2_t); return __builtin_bit_cast(unsigned, b); }
__device__ __forceinline__ float blo(unsigned w) { return __uint_as_float(w << 16); }
__device__ __forceinline__ float bhi(unsigned w) { return __uint_as_float(w & 0xffff0000u); }
__device__ __forceinline__ float fexp(float x) { return __builtin_amdgcn_exp2f(x * 1.4426950408889634f); }
__device__ __forceinline__ float frcp(float x) { return __builtin_amdgcn_rcpf(x); }
__device__ __forceinline__ float fsigmoid(float x) { return frcp(1.0f + fexp(-x)); }
__device__ __forceinline__ float fgelu_tanh(float x) { const float y = 0.7978845608028654f * (x + 0.044715f * x * x * x); const float t = 1.0f - 2.0f * frcp(fexp(2.0f * y) + 1.0f); return 0.5f * x * (1.0f + t); }
__device__ __forceinline__ float fsilu(float x) { return x * frcp(1.0f + fexp(-x)); }
__device__ __forceinline__ float neg_expm1(float x) {
    const float p = x * (1.0f + x * (0.5f + x * (0.16666667f + x * (0.041666668f + x * 0.0083333338f))));
    const float e = fexp(x) - 1.0f; return -(x > -0.1f ? p : e);
}
#define WG_BAR() do { asm volatile("s_waitcnt vmcnt(0) lgkmcnt(0)" ::: "memory"); __builtin_amdgcn_s_barrier(); asm volatile("" ::: "memory"); } while (0)

constexpr int RG_SEGS = 8, RG_SEG_T = SEQ / RG_SEGS, RG_TT = 64;
constexpr int RG_XCB = 0, RG_XS = 272;
constexpr int RG_AS = RG_XCB + 64 * RG_XS, RG_FS = 132;
constexpr int RG_US = RG_AS + 64 * RG_FS * 4;
constexpr int RG_AGG = RG_US + 64 * RG_FS * 4;
constexpr int RG_CW = RG_AGG + 4 * 128 * 2 * 4;
constexpr int RG_END = RG_CW + 5 * 128 * 4;
static_assert(RG_END <= RING_BYTES, "RG LDS map");

template <bool PASS2>
__device__ __forceinline__ void rg_unit(LAS unsigned char* L, int tid, int unit, const bf16* P, const float* cw, const float* cb, const float* wa, const float* ba, const float* wx, const float* bx,
                                        const float* lam, float* AGG, bf16* CC) {
    const int wave = __builtin_amdgcn_readfirstlane(tid >> 6);
    const int b = unit >> 6, h = (unit >> 3) & 7, s = unit & 7;
    const int jc0 = 16 * wave + (tid & 15), kq0 = (tid & 63) >> 4;
    bf16x8 Ba[4], Bx[4];
    { const float* wap = wa + (size_t)h * RG_BW * RG_BW + jc0; const float* wxp = wx + (size_t)h * RG_BW * RG_BW + jc0;
#pragma unroll
      for (int ks = 0; ks < 4; ++ks) { v4u pa, px;
#pragma unroll
        for (int e2 = 0; e2 < 4; ++e2) { const int i0 = 32 * ks + 8 * kq0 + 2 * e2;
            pa[e2] = cvtpk(wap[(size_t)i0 * RG_BW], wap[(size_t)(i0 + 1) * RG_BW]); px[e2] = cvtpk(wxp[(size_t)i0 * RG_BW], wxp[(size_t)(i0 + 1) * RG_BW]); }
        Ba[ks] = __builtin_bit_cast(bf16x8, pa); Bx[ks] = __builtin_bit_cast(bf16x8, px); } }
    const float bja = ba[h * RG_BW + jc0], bjx = bx[h * RG_BW + jc0];
    float spj; { const float nl = -lam[h * RG_BW + jc0]; spj = RG_C * (fmaxf(nl, 0.f) + log1pf(expf(-fabsf(nl)))); }
    LAS float* CW = (LAS float*)(L + RG_CW);
    CW[tid] = cw[(tid >> 7) * D_RG + h * RG_BW + (tid & 127)];
    if (tid < 128) CW[512 + tid] = cb[h * RG_BW + tid];
    const int ch0 = tid & 127;
    float carryA = 1.0f, carryH = 0.0f;
    if (PASS2) { for (int j = 0; j < s; ++j) { const f32x2_t ah = *(const f32x2_t*)(AGG + ((size_t)(b * RG_SEGS + j) * D_RG + h * RG_BW + ch0) * 2); carryH = ah.x * carryH + ah.y; } }
    WG_BAR();
#pragma unroll 1
    for (int st = 0; st < RG_SEG_T / RG_TT; ++st) {
        int t2 = tid; asm volatile("" : "+v"(t2));
        const int lane = t2 & 63, kq = lane >> 4, jc = 16 * wave + (lane & 15), ch = t2 & 127, q = t2 >> 7, tok = t2 >> 3, c0 = 16 * (t2 & 7);
        LAS float* AS = (LAS float*)(L + RG_AS); LAS float* US = (LAS float*)(L + RG_US); LAS f32x2_t* AG = (LAS f32x2_t*)(L + RG_AGG);
        const int t0 = s * RG_SEG_T + st * RG_TT; const size_t m0 = (size_t)b * SEQ + t0;
        { float xc[16];
#pragma unroll
          for (int e = 0; e < 16; ++e) xc[e] = CW[512 + c0 + e];
#pragma unroll
          for (int jj = 0; jj < 4; ++jj) { const int tt = t0 + tok - 3 + jj;
            if (tt >= 0) { const GAS v4u* xp = (const GAS v4u*)(P + (m0 + tok - 3 + jj) * NP + C_RGX + h * RG_BW + c0); const v4u x0 = xp[0], x1 = xp[1];
                const unsigned xw[8] = {x0.x, x0.y, x0.z, x0.w, x1.x, x1.y, x1.z, x1.w};
#pragma unroll
                for (int e2 = 0; e2 < 8; ++e2) { xc[2 * e2] += CW[jj * 128 + c0 + 2 * e2] * blo(xw[e2]); xc[2 * e2 + 1] += CW[jj * 128 + c0 + 2 * e2 + 1] * bhi(xw[e2]); } } }
          v4u o0, o1; o0.x = cvtpk(xc[0], xc[1]); o0.y = cvtpk(xc[2], xc[3]); o0.z = cvtpk(xc[4], xc[5]); o0.w = cvtpk(xc[6], xc[7]);
          o1.x = cvtpk(xc[8], xc[9]); o1.y = cvtpk(xc[10], xc[11]); o1.z = cvtpk(xc[12], xc[13]); o1.w = cvtpk(xc[14], xc[15]);
          LAS v4u* xo = (LAS v4u*)(L + RG_XCB + tok * RG_XS + c0 * 2); xo[0] = o0; xo[1] = o1; }
        WG_BAR();
        {
#pragma unroll
          for (int rb = 0; rb < 4; ++rb) { f32x4 ca = {0.f, 0.f, 0.f, 0.f}, cx = {0.f, 0.f, 0.f, 0.f};
#pragma unroll
            for (int ks = 0; ks < 4; ++ks) { const bf16x8 A = *(const LAS bf16x8*)(L + RG_XCB + (rb * 16 + (lane & 15)) * RG_XS + (ks * 32 + 8 * kq) * 2);
                ca = __builtin_amdgcn_mfma_f32_16x16x32_bf16(A, Ba[ks], ca, 0, 0, 0); cx = __builtin_amdgcn_mfma_f32_16x16x32_bf16(A, Bx[ks], cx, 0, 0, 0); }
#pragma unroll
            for (int r = 0; r < 4; ++r) { const int tk = rb * 16 + kq * 4 + r;
                const float rg = fsigmoid(ca[r] + bja), ig = fsigmoid(cx[r] + bjx), la = -rg * spj, a = fexp(la), m2 = neg_expm1(2.0f * la);
                const float xcv = bf2f(*(const LAS bf16*)(L + RG_XCB + tk * RG_XS + jc * 2));
                AS[tk * RG_FS + jc] = a; US[tk * RG_FS + jc] = sqrtf(m2) * ig * xcv; } } }
        WG_BAR();
        { float av[16], uv[16];
#pragma unroll
          for (int i = 0; i < 16; ++i) { av[i] = AS[(q * 16 + i) * RG_FS + ch]; uv[i] = US[(q * 16 + i) * RG_FS + ch]; }
          float ap = 1.0f, hp = 0.0f;
#pragma unroll
          for (int i = 0; i < 16; ++i) { ap *= av[i]; hp = av[i] * hp + uv[i]; }
          AG[q * 128 + ch] = (f32x2_t){ap, hp};
          WG_BAR();
          const f32x2_t g0 = AG[ch], g1 = AG[128 + ch], g2 = AG[256 + ch], g3 = AG[384 + ch];
          const float c1 = g0.x * carryH + g0.y, c2 = g1.x * c1 + g1.y, c3 = g2.x * c2 + g2.y, c4 = g3.x * c3 + g3.y;
          if (PASS2) { float hh = q == 0 ? carryH : (q == 1 ? c1 : (q == 2 ? c2 : c3));
#pragma unroll
            for (int i = 0; i < 16; ++i) { hh = av[i] * hh + uv[i]; US[(q * 16 + i) * RG_FS + ch] = hh; } }
          else carryA *= (g0.x * g1.x) * (g2.x * g3.x);
          carryH = c4; }
        if (PASS2) {
            WG_BAR();
            const GAS v4u* gp = (const GAS v4u*)(P + (m0 + tok) * NP + C_RGG + h * RG_BW + c0); const v4u g0 = gp[0], g1 = gp[1];
            const unsigned gw_[8] = {g0.x, g0.y, g0.z, g0.w, g1.x, g1.y, g1.z, g1.w};
            const LAS f32x4* hp4 = (const LAS f32x4*)(L + RG_US + (tok * RG_FS + c0) * 4);
            unsigned ow[8];
#pragma unroll
            for (int e4 = 0; e4 < 4; ++e4) { const f32x4 hv = hp4[e4];
                ow[2 * e4] = cvtpk(hv.x * fgelu_tanh(blo(gw_[2 * e4])), hv.y * fgelu_tanh(bhi(gw_[2 * e4])));
                ow[2 * e4 + 1] = cvtpk(hv.z * fgelu_tanh(blo(gw_[2 * e4 + 1])), hv.w * fgelu_tanh(bhi(gw_[2 * e4 + 1]))); }
            GAS v4u* op = (GAS v4u*)(CC + (m0 + tok) * D + h * RG_BW + c0);
            op[0] = (v4u){ow[0], ow[1], ow[2], ow[3]}; op[1] = (v4u){ow[4], ow[5], ow[6], ow[7]};
        }
    }
    if (!PASS2 && (tid >> 7) == 0) *(f32x2_t*)(AGG + ((size_t)(b * RG_SEGS + s) * D_RG + h * RG_BW + ch0) * 2) = (f32x2_t){carryA, carryH};
    WG_BAR();
}

constexpr int GLA_SEGS = 16, GLA_SEG_CH = NCHUNK / GLA_SEGS;
constexpr int GL_GS = 0, GL_GSTR = 132;
constexpr int GL_QD = GL_GS + 64 * GL_GSTR * 4, GL_QS = 272;
constexpr int GL_KI = GL_QD + 64 * GL_QS;
constexpr int GL_OS = 0, GL_OSTR = 260;
constexpr int GL_KT = GL_KI + 64 * GL_QS, GL_KTS = 320;
constexpr int GL_VS = GL_KT + 64 * GL_KTS, GL_VSS = 576;
constexpr int GL_ATT = GL_VS + 64 * GL_VSS, GL_ATS = 144;
constexpr int GL_TOT = GL_ATT + 64 * GL_ATS;
constexpr int GL_BL = GL_TOT + 2048, GL_DEC = GL_BL + 512, GL_NG = GL_DEC + 512;
constexpr int GL_END = GL_NG + 1024;
static_assert(64 * GL_OSTR * 4 <= GL_KT && GL_END <= LDSCTL_OFF, "GLA LDS map");
typedef short v4i16_t __attribute__((ext_vector_type(4)));
__device__ __forceinline__ s16x4 tr_read(const LAS unsigned char* p) { return __builtin_bit_cast(s16x4, __builtin_amdgcn_ds_read_tr16_b64_v4i16((LAS v4i16_t*)p)); }
__device__ __forceinline__ int crow(int reg, int hh) { return (reg & 3) + 8 * (reg >> 2) + 4 * hh; }
__device__ __forceinline__ f32x16 zero16() { return (f32x16){0.f, 0.f, 0.f, 0.f, 0.f, 0.f, 0.f, 0.f, 0.f, 0.f, 0.f, 0.f, 0.f, 0.f, 0.f, 0.f}; }
#define MFMA32(a, b, c) __builtin_amdgcn_mfma_f32_32x32x16_bf16((a), (b), (c), 0, 0, 0)

template <bool PASS2>
__device__ __forceinline__ void gla_unit(LAS unsigned char* L, int tid, int unit, const bf16* P, const float* GLR, const float* wg2, const float* bg2, const float* ng, float* SLOC, float* DSEG, bf16* CC) {
    const int wave = __builtin_amdgcn_readfirstlane(tid >> 6);
    const int zib = wave >> 2, zjb = wave & 3;
    const int b = unit >> 6, h = (unit >> 4) & 3, g = unit & 15;
    const size_t mbase = (size_t)b * SEQ + (size_t)g * (GLA_SEG_CH * CHUNK);
    const int lane0 = tid & 63, hh0 = lane0 >> 5, l310 = lane0 & 31;
    float bw[8];
#pragma unroll
    for (int s = 0; s < 8; ++s) bw[s] = wg2[(size_t)(2 * s + hh0) * GLA_DK + h * HK + 32 * zjb + l310];
    const float bgz = bg2[h * HK + 32 * zjb + l310];
    LAS float* GS = (LAS float*)(L + GL_GS); LAS float* TOT = (LAS float*)(L + GL_TOT); LAS float* BL = (LAS float*)(L + GL_BL); LAS float* DEC = (LAS float*)(L + GL_DEC); LAS float* NGL = (LAS float*)(L + GL_NG);
    if (PASS2 && tid < HV) NGL[tid] = ng[h * HV + tid];
    f32x16 S[4];
    float* sl = SLOC + ((size_t)unit * 8 + wave) * 4096;
#pragma unroll
    for (int db = 0; db < 4; ++db)
#pragma unroll
        for (int g4 = 0; g4 < 4; ++g4) { f32x4 v = {0.f, 0.f, 0.f, 0.f}; if (PASS2) v = *(const GAS f32x4*)(sl + ((db * 4 + g4) * 64 + lane0) * 4);
            S[db][4 * g4] = v.x; S[db][4 * g4 + 1] = v.y; S[db][4 * g4 + 2] = v.z; S[db][4 * g4 + 3] = v.w; }
    float segl = 0.f;
#pragma unroll 1
    for (int n = 0; n < GLA_SEG_CH; ++n) {
        int t2 = tid; asm volatile("" : "+v"(t2));
        const int lane = t2 & 63, hh = lane >> 5, l31 = lane & 31;
        const int tok = t2 >> 3, cg = t2 & 7, d0 = 16 * cg;
        const int sd = t2 & 127, sq = t2 >> 7;
        const int blk = (lane >> 4) & 1, qq = (lane & 15) >> 2, pp = lane & 3;
        const size_t m0 = mbase + (size_t)n * CHUNK;
        { const GAS float* gp = (const GAS float*)(GLR + (m0 + 32 * zib + l31) * GLA_RANK) + hh; float ar[8];
#pragma unroll
          for (int s = 0; s < 8; ++s) ar[s] = gp[2 * s];
          f32x16 z = zero16();
#pragma unroll
          for (int s = 0; s < 8; ++s) z = __builtin_amdgcn_mfma_f32_32x32x2f32(ar[s], bw[s], z, 0, 0, 0);
#pragma unroll
          for (int r = 0; r < 16; ++r) { const float zz = z[r] + bgz; const float sp = fmaxf(-zz, 0.f) + 0.6931471805599453f * __builtin_amdgcn_logf(1.0f + fexp(-fabsf(zz)));
              GS[(32 * zib + crow(r, hh)) * GL_GSTR + 32 * zjb + l31] = sp * (-1.0f / GLA_TAU); } }
        WG_BAR();
        { float p[16]; float run = 0.f;
#pragma unroll
          for (int i = 0; i < 16; ++i) { run += GS[(16 * sq + i) * GL_GSTR + sd]; p[i] = run; }
          TOT[sq * 128 + sd] = run;
          WG_BAR();
          const float t0 = TOT[sd], t1 = TOT[128 + sd], t2 = TOT[256 + sd], t3 = TOT[384 + sd];
          const float off = sq == 0 ? 0.f : (sq == 1 ? t0 : (sq == 2 ? t0 + t1 : (t0 + t1) + t2));
#pragma unroll
          for (int i = 0; i < 16; ++i) GS[(16 * sq + i) * GL_GSTR + sd] = p[i] + off;
          if (sq == 0) { const float tot = ((t0 + t1) + t2) + t3; BL[sd] = tot; DEC[sd] = fexp(tot); segl += tot; } }
        WG_BAR();
        { const GAS v4u* kp = (const GAS v4u*)(P + (m0 + tok) * NP + C_K + h * HK + d0); const v4u k0 = kp[0], k1 = kp[1];
          const unsigned kw[8] = {k0.x, k0.y, k0.z, k0.w, k1.x, k1.y, k1.z, k1.w};
          unsigned qw[8];
          if (PASS2) { const GAS v4u* qp = (const GAS v4u*)(P + (m0 + tok) * NP + C_Q + h * HK + d0); const v4u q0 = qp[0], q1 = qp[1];
              qw[0] = q0.x; qw[1] = q0.y; qw[2] = q0.z; qw[3] = q0.w; qw[4] = q1.x; qw[5] = q1.y; qw[6] = q1.z; qw[7] = q1.w; }
          unsigned oq[8], oi[8], ot[8];
#pragma unroll
          for (int e4 = 0; e4 < 4; ++e4) { const f32x4 bc = *(const LAS f32x4*)(L + GL_GS + (tok * GL_GSTR + d0 + 4 * e4) * 4); const f32x4 bl = *(const LAS f32x4*)(L + GL_BL + (d0 + 4 * e4) * 4);
#pragma unroll
              for (int w2 = 0; w2 < 2; ++w2) { const float b0 = w2 ? bc.z : bc.x, b1 = w2 ? bc.w : bc.y, l0 = w2 ? bl.z : bl.x, l1 = w2 ? bl.w : bl.y;
                  const float kx = blo(kw[2 * e4 + w2]), ky = bhi(kw[2 * e4 + w2]);
                  ot[2 * e4 + w2] = cvtpk(kx * fexp(l0 - b0), ky * fexp(l1 - b1));
                  if (PASS2) { const float qx = blo(qw[2 * e4 + w2]), qy = bhi(qw[2 * e4 + w2]);
                      oq[2 * e4 + w2] = cvtpk(qx * QSCALE * fexp(b0), qy * QSCALE * fexp(b1)); oi[2 * e4 + w2] = cvtpk(kx * fexp(-b0), ky * fexp(-b1)); } } }
          LAS v4u* tp = (LAS v4u*)(L + GL_KT + tok * GL_KTS + d0 * 2); tp[0] = (v4u){ot[0], ot[1], ot[2], ot[3]}; tp[1] = (v4u){ot[4], ot[5], ot[6], ot[7]};
          if (PASS2) { LAS v4u* qo = (LAS v4u*)(L + GL_QD + tok * GL_QS + d0 * 2); qo[0] = (v4u){oq[0], oq[1], oq[2], oq[3]}; qo[1] = (v4u){oq[4], oq[5], oq[6], oq[7]};
                       LAS v4u* io = (LAS v4u*)(L + GL_KI + tok * GL_QS + d0 * 2); io[0] = (v4u){oi[0], oi[1], oi[2], oi[3]}; io[1] = (v4u){oi[4], oi[5], oi[6], oi[7]}; }
#pragma unroll
          for (int i = 0; i < 4; ++i) { const int c = tid + 512 * i, row = c >> 5, chk = c & 31;
              *(LAS v4u*)(L + GL_VS + row * GL_VSS + chk * 16) = *(const GAS v4u*)(P + (m0 + row) * NP + C_V + h * HV + chk * 8); } }
        WG_BAR();
        f32x16 o[2];
        if (PASS2) {
            if (wave < 3) { const int jb = wave == 2, ib = wave >= 1; f32x16 c = zero16();
#pragma unroll
                for (int ks = 0; ks < 8; ++ks) { const bf16x8 A = *(const LAS bf16x8*)(L + GL_KI + (32 * jb + l31) * GL_QS + (16 * ks + 8 * hh) * 2);
                    const bf16x8 B = *(const LAS bf16x8*)(L + GL_QD + (32 * ib + l31) * GL_QS + (16 * ks + 8 * hh) * 2); c = MFMA32(A, B, c); }
                const int icol = 32 * ib + l31;
#pragma unroll
                for (int g4 = 0; g4 < 4; ++g4) { const int j0 = 32 * jb + 8 * g4 + 4 * hh;
                    const float c0 = (j0 + 0 <= icol) ? c[4 * g4] : 0.f, c1 = (j0 + 1 <= icol) ? c[4 * g4 + 1] : 0.f, c2 = (j0 + 2 <= icol) ? c[4 * g4 + 2] : 0.f, c3 = (j0 + 3 <= icol) ? c[4 * g4 + 3] : 0.f;
                    *(LAS f32x2_t*)(L + GL_ATT + icol * GL_ATS + j0 * 2) = __builtin_bit_cast(f32x2_t, (unsigned long long)cvtpk(c0, c1) | ((unsigned long long)cvtpk(c2, c3) << 32)); } }
            o[0] = zero16(); o[1] = zero16();
#pragma unroll
            for (int db = 0; db < 4; ++db)
#pragma unroll
                for (int s = 0; s < 2; ++s) { v4u pk; pk.x = cvtpk(S[db][8 * s], S[db][8 * s + 1]); pk.y = cvtpk(S[db][8 * s + 2], S[db][8 * s + 3]); pk.z = cvtpk(S[db][8 * s + 4], S[db][8 * s + 5]); pk.w = cvtpk(S[db][8 * s + 6], S[db][8 * s + 7]);
                    const bf16x8 Bf = __builtin_bit_cast(bf16x8, pk);
#pragma unroll
                    for (int ib = 0; ib < 2; ++ib) { const LAS unsigned char* qr = L + GL_QD + (32 * ib + l31) * GL_QS + (32 * db + 16 * s + 4 * hh) * 2;
                        const s16x4 lo = *(const LAS s16x4*)qr, hi = *(const LAS s16x4*)(qr + 16);
                        const bf16x8 Af = __builtin_shufflevector(lo, hi, 0, 1, 2, 3, 4, 5, 6, 7); o[ib] = MFMA32(Af, Bf, o[ib]); } }
            WG_BAR();
        }
        { bf16x8 vf[4];
#pragma unroll
          for (int ks = 0; ks < 4; ++ks) { const LAS unsigned char* vp = L + GL_VS + (16 * ks + 8 * hh + qq) * GL_VSS + (32 * wave + 16 * blk + 4 * pp) * 2;
              const s16x4 lo = tr_read(vp), hi = tr_read(vp + 4 * GL_VSS); vf[ks] = __builtin_shufflevector(lo, hi, 0, 1, 2, 3, 4, 5, 6, 7); }
          if (PASS2) {
#pragma unroll
              for (int ib = 0; ib < 2; ++ib)
#pragma unroll
                  for (int ks = 0; ks < 4; ++ks) if (ks < 2 * (ib + 1)) { const bf16x8 A = *(const LAS bf16x8*)(L + GL_ATT + (32 * ib + l31) * GL_ATS + (16 * ks + 8 * hh) * 2); o[ib] = MFMA32(A, vf[ks], o[ib]); } }
#pragma unroll
          for (int db = 0; db < 4; ++db) {
#pragma unroll
              for (int g4 = 0; g4 < 4; ++g4) { const f32x4 dv = *(const LAS f32x4*)(L + GL_DEC + (32 * db + 8 * g4 + 4 * hh) * 4);
                  S[db][4 * g4] *= dv.x; S[db][4 * g4 + 1] *= dv.y; S[db][4 * g4 + 2] *= dv.z; S[db][4 * g4 + 3] *= dv.w; }
#pragma unroll
              for (int ks = 0; ks < 4; ++ks) { const LAS unsigned char* kp = L + GL_KT + (16 * ks + 8 * hh + qq) * GL_KTS + (32 * db + 16 * blk + 4 * pp) * 2;
                  const s16x4 lo = tr_read(kp), hi = tr_read(kp + 4 * GL_KTS); const bf16x8 Af = __builtin_shufflevector(lo, hi, 0, 1, 2, 3, 4, 5, 6, 7);
                  S[db] = MFMA32(Af, vf[ks], S[db]); } } }
        WG_BAR();
        if (PASS2) {
#pragma unroll
            for (int ib = 0; ib < 2; ++ib)
#pragma unroll
                for (int r = 0; r < 16; ++r) *(LAS float*)(L + GL_OS + ((32 * ib + crow(r, hh)) * GL_OSTR + 32 * wave + l31) * 4) = o[ib][r];
            WG_BAR();
            { const int v0 = 32 * cg; f32x4 ov[8]; float ss = 0.f;
#pragma unroll
              for (int i = 0; i < 8; ++i) { ov[i] = *(const LAS f32x4*)(L + GL_OS + (tok * GL_OSTR + v0 + 4 * i) * 4); ss += (ov[i].x * ov[i].x + ov[i].y * ov[i].y) + (ov[i].z * ov[i].z + ov[i].w * ov[i].w); }
              ss += __shfl_xor(ss, 1); ss += __shfl_xor(ss, 2); ss += __shfl_xor(ss, 4);
              const float rs = 1.0f / sqrtf(ss * (1.0f / HV) + LN_EPS);
              const GAS v4u* rp = (const GAS v4u*)(P + (m0 + tok) * NP + C_R + h * HV + v0); GAS v4u* op = (GAS v4u*)(CC + (m0 + tok) * D + D_RG + h * HV + v0);
#pragma unroll
              for (int i = 0; i < 4; ++i) { const v4u rw = rp[i]; const f32x4 n0 = *(const LAS f32x4*)(L + GL_NG + (v0 + 8 * i) * 4), n1 = *(const LAS f32x4*)(L + GL_NG + (v0 + 8 * i + 4) * 4);
                  const f32x4 a0 = ov[2 * i], a1 = ov[2 * i + 1]; v4u w;
                  w.x = cvtpk(a0.x * rs * n0.x * fsilu(blo(rw.x)), a0.y * rs * n0.y * fsilu(bhi(rw.x))); w.y = cvtpk(a0.z * rs * n0.z * fsilu(blo(rw.y)), a0.w * rs * n0.w * fsilu(bhi(rw.y)));
                  w.z = cvtpk(a1.x * rs * n1.x * fsilu(blo(rw.z)), a1.y * rs * n1.y * fsilu(bhi(rw.z))); w.w = cvtpk(a1.z * rs * n1.z * fsilu(blo(rw.w)), a1.w * rs * n1.w * fsilu(bhi(rw.w)));
                  op[i] = w; } }
            WG_BAR();
        }
    }
    if (!PASS2) {
#pragma unroll
        for (int db = 0; db < 4; ++db)
#pragma unroll
            for (int g4 = 0; g4 < 4; ++g4) *(GAS f32x4*)(sl + ((db * 4 + g4) * 64 + lane0) * 4) = (f32x4){S[db][4 * g4], S[db][4 * g4 + 1], S[db][4 * g4 + 2], S[db][4 * g4 + 3]};
        if ((tid >> 7) == 0) DSEG[(size_t)unit * HK + (tid & 127)] = fexp(segl);
    }
    WG_BAR();
}
__device__ __forceinline__ void gla_prefix(float* SLOC, const float* DSEG, size_t gt, size_t NT) {
    for (size_t i = gt; i < (size_t)BATCH * GLA_H * 8192; i += NT) { const int bh = (int)(i >> 13), e4 = (int)(i & 8191), lane = e4 & 63, g4 = (e4 >> 6) & 3, db = (e4 >> 8) & 3;
        const int d = 32 * db + 8 * g4 + 4 * (lane >> 5);
        f32x4 x[GLA_SEGS], dv[GLA_SEGS];
#pragma unroll
        for (int g = 0; g < GLA_SEGS; ++g) { x[g] = *(const GAS f32x4*)(SLOC + ((size_t)(bh * GLA_SEGS + g) * 8192 + e4) * 4); dv[g] = *(const GAS f32x4*)(DSEG + (size_t)(bh * GLA_SEGS + g) * HK + d); }
        f32x4 s = {0.f, 0.f, 0.f, 0.f};
#pragma unroll
        for (int g = 0; g < GLA_SEGS; ++g) { *(GAS f32x4*)(SLOC + ((size_t)(bh * GLA_SEGS + g) * 8192 + e4) * 4) = s; s = dv[g] * s + x[g]; } }
}

struct Args { const float* in[24]; float* out; unsigned char* ws; int ph_lo, ph_hi; };
typedef const __attribute__((address_space(4))) unsigned char* kargp_t;
__device__ __forceinline__ const float* karg_in(int i) { kargp_t ka = (kargp_t)__builtin_amdgcn_kernarg_segment_ptr(); asm volatile("" : "+s"(ka)); return *(const float* const __attribute__((address_space(4)))*)(ka + 8 * i); }
__device__ __forceinline__ float* karg_out() { kargp_t ka = (kargp_t)__builtin_amdgcn_kernarg_segment_ptr(); asm volatile("" : "+s"(ka)); return *(float* const __attribute__((address_space(4)))*)(ka + 8 * 24); }
__device__ __forceinline__ unsigned char* karg_ws() { kargp_t ka = (kargp_t)__builtin_amdgcn_kernarg_segment_ptr(); asm volatile("" : "+s"(ka)); return *(unsigned char* const __attribute__((address_space(4)))*)(ka + 8 * 25); }
#define IN(i) karg_in(i)
__global__ void __launch_bounds__(NWAVES * 64, 2) mk_fwd(Args args) {
    extern __shared__ __attribute__((aligned(16))) unsigned char lds[];
    LAS unsigned char* const L0 = (LAS unsigned char*)lds;
    volatile LAS unsigned* const MISC = (volatile LAS unsigned*)(L0 + MISC_OFF);
    const int G0 = gridDim.x; const int bx0 = blockIdx.x; const int vcu0 = (G0 % 8 == 0) ? (bx0 % 8) * (G0 / 8) + bx0 / 8 : bx0;
    const int wave0 = __builtin_amdgcn_readfirstlane((int)threadIdx.x >> 6);
#define MK_TID() (mk_wave() * 64 + (int)__builtin_amdgcn_mbcnt_hi(~0u, __builtin_amdgcn_mbcnt_lo(~0u, 0u)))
    auto mk_wave = [&]() { int w = wave0; asm volatile("" : "+s"(w)); return w; };
    for (int u = MK_TID(); u < (LDS_BYTES - LDSCTL_OFF) / 4; u += NWAVES * 64) ((LAS unsigned*)(L0 + LDSCTL_OFF))[u] = 0u;
    __syncthreads();
    XcdBarrier bar; bar.bar = (unsigned*)(karg_ws() + WS_CTL) + CW_BAR; bar.x = 0; bar.st = nullptr;
    if (!MK_LAUNCH_PER_PHASE) bar = xcd_barrier_post((unsigned*)(karg_ws() + WS_CTL) + CW_BAR, MISC + 8, MK_TID());
#if MK_LAUNCH_PER_PHASE
    const int lo = args.ph_lo, hi = args.ph_hi; int pid = 0;
#define PH_ON() (pid >= lo && pid < hi)
#define PH_END() do { ++pid; } while (0)
#else
    (void)args;
#define PH_ON() true
#define PH_END() xcd_barrier(bar, MK_TID())
#endif
#define PH_LOCALS() int tid = MK_TID(); asm volatile("" : "+v"(tid)); const int lane = tid & 63, wave = __builtin_amdgcn_readfirstlane(tid >> 6); \
    int G = G0, bx = bx0, vcu = vcu0; asm volatile("" : "+s"(G), "+s"(bx), "+s"(vcu)); LAS unsigned char* L = L0; asm volatile("" : "+s"(L)); \
    unsigned char* const ws = karg_ws(); const int gw = vcu * NWAVES + wave, NGW = G * NWAVES; \
    const size_t gt = (size_t)vcu * (NWAVES * 64) + tid, NT = (size_t)G * (NWAVES * 64); \
    float* const MOD = (float*)(ws + WS_MOD); float* const GLR = (float*)(ws + WS_GLR); \
    bf16* const P = (bf16*)(ws + WS_P); bf16* const CC = (bf16*)(ws + WS_CONCAT); bf16* const U = (bf16*)(ws + WS_U); \
    float* const V = (float*)(ws + WS_V); float* const X1 = (float*)(ws + WS_X1); bf16* const HDN = (bf16*)(ws + WS_HDN); \
    (void)L; (void)bx; (void)lane; (void)wave; (void)gw; (void)NGW; (void)gt; (void)NT; (void)MOD; (void)GLR; (void)P; (void)CC; (void)U; (void)V; (void)X1; (void)HDN;

    if (PH_ON()) { PH_LOCALS();
        LAS float* scr = (LAS float*)(L + RING_OFF + wave * 16384);
        constexpr int I_IN = (D / 64) * (NP / 32), I_OUT = (D / 64) * (D / 32), I_UP = (D / 64) * (FF / 32), I_DOWN = (FF / 64) * (D / 32), I_L = I_IN + I_OUT + I_UP + I_DOWN;
        for (int it = gw; it < DEPTH * I_L; it += NGW) {
            const int l = it / I_L; int r = it % I_L; unsigned char* wl = ws + WS_W + (size_t)l * W_LAYER;
            if (r < I_IN) { p0_transpose_item(IN(4) + (size_t)l * D * D_IN, D, D_IN, (bf16*)(wl + WO_IN), scr, r, lane); continue; } r -= I_IN;
            if (r < I_OUT) { p0_transpose_item(IN(15) + (size_t)l * D * D, D, D, (bf16*)(wl + WO_OUT), scr, r, lane); continue; } r -= I_OUT;
            if (r < I_UP) { p0_transpose_item(IN(18) + (size_t)l * D * FF, D, FF, (bf16*)(wl + WO_UP), scr, r, lane); continue; } r -= I_UP;
            p0_transpose_item(IN(20) + (size_t)l * FF * D, FF, D, (bf16*)(wl + WO_DOWN), scr, r, lane);
        }
        { const float* w_in = IN(4);
        for (size_t i = gt; i < (size_t)DEPTH * GLA_RANK * D; i += NT) { const int l = (int)(i / (GLA_RANK * D)), j = (int)((i / D) % GLA_RANK), k = (int)(i % D);
            ((bf16*)(ws + WS_W + (size_t)l * W_LAYER + WO_GLR))[j * D + k] = (bf16)f2bf(w_in[(size_t)l * D * D_IN + (size_t)k * D_IN + C_GLR + j]); } }
        __syncthreads();
        mod_phase(IN(1), IN(2), IN(3), MOD, L, vcu, G, tid);
    }
    PH_END();
    if (PH_ON()) { PH_LOCALS(); modulate_rows(IN(0), MOD + 0 * D, MOD + 1 * D, U, gw, NGW, lane); }
    PH_END();

    for (int l = 0; l < DEPTH; ++l) {
#define WL() (ws + WS_W + (size_t)l * W_LAYER)
#define MODL() (MOD + (size_t)l * BATCH * NMOD)
        if (PH_ON()) { PH_LOCALS();
            pg8::Gemm g{U, (const bf16*)(WL() + WO_IN), M, NP, D}; pg8::StaticOrder S; S.init(M, NP, G, bx);
            pg8::EpiBf16<0> E{P, NP, nullptr};
            pg8::gemm_phase<pg8::EpiBf16<0>, pg8::StaticOrder, true, true>(L + RING_OFF, tid, g, S, E);
            glr_rows(U, (const bf16*)(WL() + WO_GLR), GLR, gw, NGW, lane);
        }
        PH_END();
#define RG_ARGS() IN(5) + (size_t)l * 4 * D_RG, IN(6) + (size_t)l * D_RG, IN(7) + (size_t)l * D_RG * RG_BW, IN(8) + (size_t)l * D_RG, IN(9) + (size_t)l * D_RG * RG_BW, IN(10) + (size_t)l * D_RG, IN(11) + (size_t)l * D_RG, (float*)(ws + WS_RGAGG), CC
#define GLA_ARGS() GLR, IN(12) + (size_t)l * GLA_RANK * GLA_DK, IN(13) + (size_t)l * GLA_DK, IN(14) + (size_t)l * GLA_DV, (float*)(ws + WS_SLOC), (float*)(ws + WS_DSEG), CC
        if (PH_ON()) { PH_LOCALS();
            for (int unit = vcu; unit < BATCH * 8 * RG_SEGS; unit += G) rg_unit<false>(L, tid, unit, P, RG_ARGS());
            for (int unit = vcu; unit < BATCH * GLA_H * GLA_SEGS; unit += G) gla_unit<false>(L, tid, unit, P, GLA_ARGS()); }
        PH_END();
        if (PH_ON()) { PH_LOCALS(); gla_prefix((float*)(ws + WS_SLOC), (const float*)(ws + WS_DSEG), gt, NT); }
        PH_END();
        if (PH_ON()) { PH_LOCALS();
            for (int unit = vcu; unit < BATCH * 8 * RG_SEGS; unit += G) rg_unit<true>(L, tid, unit, P, RG_ARGS());
            for (int unit = vcu; unit < BATCH * GLA_H * GLA_SEGS; unit += G) gla_unit<true>(L, tid, unit, P, GLA_ARGS()); }
        PH_END();
        if (PH_ON()) { PH_LOCALS();
            const float* const xprev = (l == 0) ? IN(0) : karg_out();
            pg8::Gemm g{CC, (const bf16*)(WL() + WO_OUT), M, D, D}; pg8::StaticOrder S; S.init(M, D, G, bx);
            pg8::EpiRes E{V, D, nullptr, xprev, MODL() + 2 * D, NMOD, SEQ / 256, ALPHA};
            pg8::gemm_phase<pg8::EpiRes, pg8::StaticOrder, true, true>(L + RING_OFF, tid, g, S, E);
        }
        PH_END();
        if (PH_ON()) { PH_LOCALS(); ln_rows(V, IN(16) + (size_t)l * D, IN(17) + (size_t)l * D, X1, MODL() + 3 * D, MODL() + 4 * D, U, gw, NGW, lane); }
        PH_END();
        if (PH_ON()) { PH_LOCALS();
            pg8::Gemm g{U, (const bf16*)(WL() + WO_UP), M, FF, D}; pg8::StaticOrder S; S.init(M, FF, G, bx);
            pg8::EpiBf16<3> E{HDN, FF, IN(19) + (size_t)l * FF};
            pg8::gemm_phase<pg8::EpiBf16<3>, pg8::StaticOrder, true, true>(L + RING_OFF, tid, g, S, E);
        }
        PH_END();
        if (PH_ON()) { PH_LOCALS();
            pg8::Gemm g{HDN, (const bf16*)(WL() + WO_DOWN), M, D, FF}; pg8::StaticOrder S; S.init(M, D, G, bx);
            pg8::EpiRes E{V, D, IN(21) + (size_t)l * D, X1, MODL() + 5 * D, NMOD, SEQ / 256, ALPHA};
            pg8::gemm_phase<pg8::EpiRes, pg8::StaticOrder, true, true>(L + RING_OFF, tid, g, S, E);
        }
        PH_END();
        if (PH_ON()) { PH_LOCALS();
            const bool more = (l + 1 < DEPTH); const float* modn = MOD + (size_t)(more ? l + 1 : l) * BATCH * NMOD;
            ln_rows(V, IN(22) + (size_t)l * D, IN(23) + (size_t)l * D, karg_out(), modn + 0 * D, modn + 1 * D, more ? U : (bf16*)nullptr, gw, NGW, lane);
        }
        PH_END();
    }
    if (!MK_LAUNCH_PER_PHASE) {
        if (bx0 == 0 && MK_TID() == 0 && __hip_atomic_load((gu32*)((unsigned*)(karg_ws() + WS_CTL) + CW_BAR + XB_TMO), RLX_AGENT) != 0u) karg_out()[0] = __builtin_nanf("");
    }
#undef PH_ON
#undef PH_END
}
constexpr int N_PHASES = 2 + DEPTH * 9;

extern "C" void kernel_launch(void* const* d_in, const int* in_sizes, int n_in, void* d_out, int out_size, void* d_ws, size_t ws_size, hipStream_t stream) {
    static int grid = 0;
    if (grid == 0) {
        if (n_in != 24 || in_sizes[0] != M * D || out_size != M * D || ws_size < WS_END) { fprintf(stderr, "kernel_launch: unexpected shapes / workspace: n_in %d in0 %d out %d ws %zu (need %zu)\n", n_in, n_in > 0 ? in_sizes[0] : -1, out_size, ws_size, (size_t)WS_END); grid = -1; return; }
        int dev = 0, cus = 0, per_cu = 0;
        if (hipGetDevice(&dev) != hipSuccess || hipDeviceGetAttribute(&cus, hipDeviceAttributeMultiprocessorCount, dev) != hipSuccess) { fprintf(stderr, "kernel_launch: device query failed\n"); grid = -1; return; }
        if (hipFuncSetAttribute((const void*)mk_fwd, hipFuncAttributeMaxDynamicSharedMemorySize, LDS_BYTES) != hipSuccess) { fprintf(stderr, "kernel_launch: hipFuncSetAttribute failed\n"); grid = -1; return; }
        if (hipOccupancyMaxActiveBlocksPerMultiprocessor(&per_cu, (const void*)mk_fwd, NWAVES * 64, LDS_BYTES) != hipSuccess || per_cu < 1)
            fprintf(stderr, "kernel_launch: note: occupancy query reports %d workgroups per CU\n", per_cu);
        (void)hipGetLastError();
        grid = cus;
    }
    if (grid < 0) return;
    if (hipMemsetAsync((char*)d_ws + WS_CTL, 0, CTL_ZERO_BYTES, stream) != hipSuccess) { fprintf(stderr, "kernel_launch: memset failed\n"); return; }
    Args a{};
    for (int i = 0; i < 24; ++i) a.in[i] = (const float*)d_in[i];
    a.out = (float*)d_out; a.ws = (unsigned char*)d_ws;
#if MK_LAUNCH_PER_PHASE
    for (int p = 0; p < N_PHASES; ++p) { a.ph_lo = p; a.ph_hi = p + 1; hipLaunchKernelGGL(mk_fwd, dim3(grid), dim3(NWAVES * 64), LDS_BYTES, stream, a); }
#else
    a.ph_lo = 0; a.ph_hi = N_PHASES;
    hipLaunchKernelGGL(mk_fwd, dim3(grid), dim3(NWAVES * 64), LDS_BYTES, stream, a);
#endif
    const hipError_t le = hipPeekAtLastError();
    if (le != hipSuccess) fprintf(stderr, "kernel_launch: launch failed: %s\n", hipGetErrorName(le));
}
```

```cpp
#include <hip/hip_runtime.h>
#include <cstdio>
#include <cstdint>
#ifndef MK_LAUNCH_PER_PHASE
#define MK_LAUNCH_PER_PHASE 0
#endif
#define REP_PRO 1
#define REP_GEMM 1
#define REP_MIX 1
#define REP_LN 1
#define REP_G_IN 1
#define REP_G_OUT 1
#define REP_G_UP 1
#define REP_G_DOWN 1
#define REP_RG1 1
#define REP_GLA1 1
#define REP_RG2 1
#define REP_GLA2 1
#define REP_GLR 1
namespace pg8 {
#define PG8_LAS __attribute__((address_space(3)))
typedef unsigned short bf16_t;
typedef short bf16x8 __attribute__((ext_vector_type(8)));
typedef float f32x4 __attribute__((ext_vector_type(4)));
typedef unsigned u32x4 __attribute__((ext_vector_type(4)));
constexpr int BM = 256, BK = 64, HALF = 128, HTB = HALF * BK * 2  , STAGE_BYTES = 8 * HTB, NXCD = 8, WGM = 8;

__host__ __device__ __forceinline__ int lds_byte(int r, int c) { const int st = (r >> 4) * 2 + (c >> 5), rr = r & 15, cc = c & 31, ob = rr * 64 + cc * 2; return st * 1024 + (ob ^ (((ob >> 9) & 1) << 5)); }
__host__ __device__ __forceinline__ void stage_rc(int b, int& R, int& C) { const int st = b / 1024, sb = b % 1024, swz = sb ^ (((sb >> 9) & 1) << 5); R = (st >> 1) * 16 + swz / 64; C = (st & 1) * 32 + (swz % 64) / 2; }
__host__ __device__ __forceinline__ int perm32(int rho) { const int n = rho >> 4, i = rho & 15; return 8 * (i >> 2) + 4 * n + (i & 3); }

struct Unit { int pm, pn; };
struct Gemm { const bf16_t* A; const bf16_t* Bt; int M, N, K; };

struct StaticOrder {
    int nM, nN, nwg, G, c;
    __host__ __device__ void init(int M, int N, int G_, int c_) { nM = M / BM; nN = N / BM; nwg = nM * nN; G = G_; c = c_; }
    __host__ __device__ bool next(int i, Unit& u) const {
        const long L = (long)i * G + c; if (L >= nwg) return false;
        int wgid = (int)L; { const int q = nwg / NXCD, r = nwg % NXCD, xcd = wgid % NXCD, off = wgid / NXCD; wgid = (xcd < r ? xcd * (q + 1) : r * (q + 1) + (xcd - r) * q) + off; }
        const int nig = WGM * nN, gid = wgid / nig, fm = gid * WGM, gsz = (nM - fm) < WGM ? (nM - fm) : WGM;
        u.pm = fm + ((wgid % nig) % gsz); u.pn = (wgid % nig) / gsz; return true;
    }
    __device__ __forceinline__ void a_ready(const Unit&) const {}
    __device__ __forceinline__ void done(const Unit&) const {}
};

__device__ __forceinline__ unsigned cvt_pk_bf16(float lo, float hi) { unsigned r; asm volatile("v_cvt_pk_bf16_f32 %0, %1, %2" : "=v"(r) : "v"(lo), "v"(hi)); return r; }
typedef float f32x2 __attribute__((ext_vector_type(2)));

template <int ACT> struct EpiBf16 {
    static constexpr bool PERM = true, AFTER_DRAIN = false;
    bf16_t* O; int ldc; const float* bias;
    __device__ __forceinline__ void operator()(const f32x4 (&acc)[2][2][4][2], const Unit& u, int wr, int wc, int fr, int fq) const {
        const int row0 = u.pm * BM + wr * 64 + fr; const int colt = u.pn * BM; bf16_t* base = O;
        const int col0 = colt + wc * 32 + 8 * fq;
        f32x4 bv[2][2];
#pragma unroll
        for (int bj = 0; bj < 2; ++bj)
#pragma unroll
            for (int n = 0; n < 2; ++n) bv[bj][n] = bias ? *(const f32x4*)(bias + col0 + bj * HALF + 4 * n) : (f32x4){0.f, 0.f, 0.f, 0.f};
#pragma unroll
        for (int ai = 0; ai < 2; ++ai)
#pragma unroll
            for (int m = 0; m < 4; ++m) { bf16_t* rowp = base + (size_t)(row0 + ai * HALF + m * 16) * ldc + col0;
#pragma unroll
                for (int bj = 0; bj < 2; ++bj) { f32x4 v0 = acc[ai][bj][m][0] + bv[bj][0], v1 = acc[ai][bj][m][1] + bv[bj][1];
                    if (ACT == 3) {
#pragma unroll
                        for (int j = 0; j < 4; ++j) { const float a = fmaxf(v0[j], 0.f), b = fmaxf(v1[j], 0.f); v0[j] = a * a; v1[j] = b * b; } }
                    u32x4 w; w.x = cvt_pk_bf16(v0[0], v0[1]); w.y = cvt_pk_bf16(v0[2], v0[3]); w.z = cvt_pk_bf16(v1[0], v1[1]); w.w = cvt_pk_bf16(v1[2], v1[3]);
                    *(u32x4*)(rowp + bj * HALF) = w; } }
    }
};
struct EpiRes {
    static constexpr bool PERM = false, AFTER_DRAIN = false;
    float* C; int ldc; const float* bias; const float* res; const float* gate; int gate_pitch; int panels_per_batch; float alpha;
    __device__ __forceinline__ void operator()(const f32x4 (&acc)[2][2][4][2], const Unit& u, int wr, int wc, int fr, int fq) const {
        const int row0 = u.pm * BM + wr * 64 + fr, col0 = u.pn * BM + wc * 32 + 4 * fq;
        const float* gp = gate + (size_t)(u.pm / panels_per_batch) * gate_pitch;
        f32x4 bv[2][2], gv[2][2];
#pragma unroll
        for (int bj = 0; bj < 2; ++bj)
#pragma unroll
            for (int n = 0; n < 2; ++n) { bv[bj][n] = bias ? *(const f32x4*)(bias + col0 + bj * HALF + n * 16) : (f32x4){0.f, 0.f, 0.f, 0.f};
                gv[bj][n] = *(const f32x4*)(gp + col0 + bj * HALF + n * 16) + 1.0f; }
#pragma unroll
        for (int ai = 0; ai < 2; ++ai)
#pragma unroll
            for (int m = 0; m < 4; ++m) { const size_t off = (size_t)(row0 + ai * HALF + m * 16) * ldc + col0;
#pragma unroll
                for (int bj = 0; bj < 2; ++bj)
#pragma unroll
                    for (int n = 0; n < 2; ++n) { const f32x4 r = *(const f32x4*)(res + off + bj * HALF + n * 16);
                        *(f32x4*)(C + off + bj * HALF + n * 16) = r * alpha + gv[bj][n] * (acc[ai][bj][m][n] + bv[bj][n]); }
                asm volatile("" ::: "memory"); }
    }
};

template <class Epi, class Sched, bool ALIGN_EPI = false, bool SP2 = false>
__device__ __forceinline__ void gemm_phase(PG8_LAS unsigned char* lds, int tid_in, const Gemm g, const Sched& S, const Epi& E) {
    int tid = tid_in; asm volatile("" : "+v"(tid));
    const int wid = __builtin_amdgcn_readfirstlane(tid >> 6), lane = tid & 63, wr = wid >> 2, wc = wid & 3, fr = lane & 15, fq = lane >> 4;
    const int K = g.K, nt = K / BK;
    unsigned voffA[2], voffB[2];
#pragma unroll
    for (int i = 0; i < 2; ++i) { int R, C; stage_rc(tid * 16 + i * 8192, R, C); const int Rb = Epi::PERM ? ((R & ~31) + perm32(R & 31)) : R;
        voffA[i] = (unsigned)(R * K + C) * 2u; voffB[i] = (unsigned)(Rb * K + C) * 2u; }
    const size_t kstep = (size_t)(BK * 2);
    const size_t hstep = (size_t)HALF * K * 2;
    const size_t tstep = 2 * hstep;
    const unsigned ldsw = (unsigned)wid * 1024u;
    const int aoff = lds_byte(wr * 64 + fr, fq * 8), boff = lds_byte(wc * 32 + fr, fq * 8);
#define PG8_SA(b, h) (((b) * 2 + (h)) * HTB)
#define PG8_SB(b, h) ((4 + (b) * 2 + (h)) * HTB)
#define PG8_STAGE(bufoff, gbase, voff) do { _Pragma("unroll") for (int _i = 0; _i < 2; ++_i) \
        __builtin_amdgcn_global_load_lds((const unsigned*)((const char*)(gbase) + (voff)[_i]), (PG8_LAS unsigned*)(lds + (bufoff) + ldsw + _i * 8192), 16, 0, 0); } while (0)
#define PG8_LDA(dst, b, h) do { _Pragma("unroll") for (int m = 0; m < 4; ++m) _Pragma("unroll") for (int k = 0; k < 2; ++k) dst[m][k] = *(const PG8_LAS bf16x8*)(lds + PG8_SA(b, h) + aoff + m * 2048 + k * 1024); } while (0)
#define PG8_LDB(dst, b, h) do { _Pragma("unroll") for (int n = 0; n < 2; ++n) _Pragma("unroll") for (int k = 0; k < 2; ++k) dst[n][k] = *(const PG8_LAS bf16x8*)(lds + PG8_SB(b, h) + boff + n * 2048 + k * 1024); } while (0)
#define PG8_MMA(ai, bj, At, Bt) do { __builtin_amdgcn_s_setprio(1); _Pragma("unroll") for (int m = 0; m < 4; ++m) _Pragma("unroll") for (int n = 0; n < 2; ++n) _Pragma("unroll") for (int k = 0; k < 2; ++k) \
        acc[ai][bj][m][n] = __builtin_amdgcn_mfma_f32_16x16x32_bf16(Bt[n][k], At[m][k], acc[ai][bj][m][n], 0, 0, 0); __builtin_amdgcn_s_setprio(0); } while (0)
#define PG8_WAIT_V(n) asm volatile("s_waitcnt vmcnt(" #n ")" ::: "memory")
#define PG8_WAIT_L(n) asm volatile("s_waitcnt lgkmcnt(" #n ")" ::: "memory")
#define PG8_BAR __builtin_amdgcn_s_barrier()
#define PG8_SCHED __builtin_amdgcn_sched_barrier(0)
    Unit cur, nxt; int ui = 0;
    if (!S.next(0, cur)) return;
    f32x4 acc[2][2][4][2];
#pragma unroll
    for (int a = 0; a < 2; ++a)
#pragma unroll
        for (int b = 0; b < 2; ++b)
#pragma unroll
            for (int m = 0; m < 4; ++m)
#pragma unroll
                for (int n = 0; n < 2; ++n) acc[a][b][m][n] = (f32x4){0.f, 0.f, 0.f, 0.f};
    bf16x8 At[4][2], B0[2][2], B1[2][2];
    const char* cA = (const char*)g.A + (size_t)cur.pm * tstep; const char* cB = (const char*)g.Bt + (size_t)cur.pn * tstep;
    S.a_ready(cur);
    if constexpr (SP2) {
        PG8_STAGE(PG8_SB(0, 0), cB, voffB); PG8_STAGE(PG8_SB(0, 1), cB + hstep, voffB); PG8_STAGE(PG8_SA(0, 0), cA, voffA); PG8_STAGE(PG8_SA(0, 1), cA + hstep, voffA);
        if (wr == 1) PG8_BAR;
        PG8_WAIT_V(2); PG8_BAR;
        PG8_STAGE(PG8_SB(1, 0), cB + kstep, voffB); PG8_STAGE(PG8_SA(1, 0), cA + kstep, voffA); PG8_STAGE(PG8_SB(1, 1), cB + hstep + kstep, voffB);
        PG8_WAIT_V(6); PG8_BAR;
    } else {
        PG8_STAGE(PG8_SB(0, 0), cB, voffB); PG8_STAGE(PG8_SA(0, 0), cA, voffA); PG8_STAGE(PG8_SB(0, 1), cB + hstep, voffB); PG8_STAGE(PG8_SA(0, 1), cA + hstep, voffA);
        if (wr == 1) PG8_BAR;
        PG8_WAIT_V(4); PG8_BAR;
        PG8_STAGE(PG8_SB(1, 0), cB + kstep, voffB); PG8_STAGE(PG8_SA(1, 0), cA + kstep, voffA); PG8_STAGE(PG8_SB(1, 1), cB + hstep + kstep, voffB);
        PG8_WAIT_V(6); PG8_BAR;
    }
    for (;;) {
        const bool has_next = S.next(ui + 1, nxt);
        const char* nA = has_next ? (const char*)g.A + (size_t)nxt.pm * tstep : cA; const char* nB = has_next ? (const char*)g.Bt + (size_t)nxt.pn * tstep : cB;
        for (int t = 0; t < nt; t += 2) {
            const bool last = (t == nt - 2);
            const char* a1 = cA + (size_t)(t + 1) * kstep;
            const char* a2 = last ? nA : cA + (size_t)(t + 2) * kstep; const char* b2 = last ? nB : cB + (size_t)(t + 2) * kstep;
            const char* a3 = a2 + kstep; const char* b3 = b2 + kstep;
            if (last && has_next) S.a_ready(nxt);
            if constexpr (SP2) {
            PG8_LDB(B0, 0, 0); PG8_LDB(B1, 0, 1); PG8_SCHED; PG8_LDA(At, 0, 0); PG8_STAGE(PG8_SA(1, 1), a1 + hstep, voffA);
            PG8_WAIT_V(8); PG8_WAIT_L(0); PG8_BAR; PG8_MMA(0, 0, At, B0); PG8_MMA(0, 1, At, B1); PG8_BAR; PG8_SCHED;
            PG8_LDA(At, 0, 1); PG8_STAGE(PG8_SB(0, 0), b2, voffB); PG8_STAGE(PG8_SB(0, 1), b2 + hstep, voffB); PG8_STAGE(PG8_SA(0, 0), a2, voffA);
            PG8_WAIT_V(8); PG8_WAIT_L(0); PG8_BAR; PG8_MMA(1, 0, At, B0); PG8_MMA(1, 1, At, B1); PG8_BAR; PG8_SCHED;
            PG8_LDB(B0, 1, 0); PG8_LDB(B1, 1, 1); PG8_SCHED; PG8_LDA(At, 1, 0); PG8_STAGE(PG8_SA(0, 1), a2 + hstep, voffA);
            PG8_WAIT_V(8); PG8_WAIT_L(0); PG8_BAR; PG8_MMA(0, 0, At, B0); PG8_MMA(0, 1, At, B1); PG8_BAR; PG8_SCHED;
            PG8_LDA(At, 1, 1); PG8_STAGE(PG8_SB(1, 0), b3, voffB); PG8_STAGE(PG8_SB(1, 1), b3 + hstep, voffB); PG8_STAGE(PG8_SA(1, 0), a3, voffA);
            PG8_WAIT_V(8); PG8_WAIT_L(0); PG8_BAR; PG8_MMA(1, 0, At, B0); PG8_MMA(1, 1, At, B1); PG8_BAR; PG8_SCHED;
            } else {
            PG8_LDB(B0, 0, 0); PG8_SCHED; PG8_LDA(At, 0, 0); PG8_STAGE(PG8_SA(1, 1), a1 + hstep, voffA);
            PG8_WAIT_L(8); PG8_BAR; PG8_WAIT_L(0); PG8_MMA(0, 0, At, B0); PG8_BAR; PG8_SCHED;
            PG8_LDB(B1, 0, 1); PG8_STAGE(PG8_SB(0, 0), b2, voffB);
            PG8_BAR; PG8_WAIT_L(0); PG8_MMA(0, 1, At, B1); PG8_BAR;
            PG8_LDA(At, 0, 1); PG8_STAGE(PG8_SA(0, 0), a2, voffA);
            PG8_BAR; PG8_WAIT_L(0); PG8_MMA(1, 0, At, B0); PG8_BAR; PG8_SCHED;
            PG8_STAGE(PG8_SB(0, 1), b2 + hstep, voffB);
            PG8_WAIT_V(6); PG8_BAR; PG8_MMA(1, 1, At, B1); PG8_BAR;
            PG8_LDB(B0, 1, 0); PG8_SCHED; PG8_LDA(At, 1, 0); PG8_STAGE(PG8_SA(0, 1), a2 + hstep, voffA);
            PG8_WAIT_L(8); PG8_BAR; PG8_WAIT_L(0); PG8_MMA(0, 0, At, B0); PG8_BAR; PG8_SCHED;
            PG8_LDB(B1, 1, 1); PG8_STAGE(PG8_SB(1, 0), b3, voffB);
            PG8_BAR; PG8_WAIT_L(0); PG8_MMA(0, 1, At, B1); PG8_BAR;
            PG8_LDA(At, 1, 1); PG8_STAGE(PG8_SA(1, 0), a3, voffA);
            PG8_BAR; PG8_WAIT_L(0); PG8_MMA(1, 0, At, B0); PG8_BAR; PG8_SCHED;
            PG8_STAGE(PG8_SB(1, 1), b3 + hstep, voffB);
            PG8_WAIT_V(6); PG8_BAR; PG8_MMA(1, 1, At, B1); PG8_BAR;
            }
        }
        if constexpr (ALIGN_EPI) { if (wr == 0) PG8_BAR; }
        if constexpr (!Epi::AFTER_DRAIN) { E(acc, cur, wr, wc, fr, fq); S.done(cur); }
        if (!has_next) break;
#pragma unroll
        for (int a = 0; a < 2; ++a)
#pragma unroll
            for (int b = 0; b < 2; ++b)
#pragma unroll
                for (int m = 0; m < 4; ++m)
#pragma unroll
                    for (int n = 0; n < 2; ++n) acc[a][b][m][n] = (f32x4){0.f, 0.f, 0.f, 0.f};
        cur = nxt; cA = nA; cB = nB; ++ui;
        if constexpr (ALIGN_EPI) { if (wr == 1) PG8_BAR; }
    }
    PG8_WAIT_V(0);
    if constexpr (!ALIGN_EPI) { if (wr == 0) PG8_BAR; }
    PG8_BAR;
    if constexpr (Epi::AFTER_DRAIN) { E.fused(acc, cur, wr, wc, fr, fq, lds, wid, lane); S.done(cur); }
#undef PG8_SA
#undef PG8_SB
#undef PG8_STAGE
#undef PG8_LDA
#undef PG8_LDB
#undef PG8_MMA
#undef PG8_WAIT_V
#undef PG8_WAIT_L
#undef PG8_BAR
#undef PG8_SCHED
}
}

constexpr int NWAVES = 8;
constexpr int BATCH = 4, SEQ = 4096, D = 2048, DEPTH = 4;
constexpr int M = BATCH * SEQ;
constexpr int D_RG = 1024, RG_BW = 128;
constexpr int GLA_H = 4, GLA_DK = 512, GLA_DV = 1024, HK = 128, HV = 256, GLA_RANK = 16, CHUNK = 64, NCHUNK = SEQ / CHUNK;
constexpr int D_IN = 5136, NP = 5120;
constexpr int FF = 8192, NMOD = 6 * D;
constexpr int C_RGX = 0, C_RGG = 1024, C_Q = 2048, C_K = 2560, C_V = 3072, C_R = 4096, C_GLR = 5120;
constexpr float ALPHA = 1.6817928305074290f;
constexpr float LN_EPS = 1e-5f;
constexpr float RG_C = 8.0f, GLA_TAU = 16.0f;
constexpr float QSCALE = 0.08838834764831845f;

constexpr size_t MiB = 1u << 20;
constexpr size_t WS_CTL = 0, CTL_ZERO_BYTES = 1 * MiB;
constexpr size_t WS_MOD = 1 * MiB;
constexpr size_t WS_GLR = 2 * MiB;
constexpr size_t WS_DSEG = 4 * MiB;
constexpr size_t WS_SLOC = 672 * MiB;
constexpr size_t WS_RGAGG = 3 * MiB;
constexpr size_t WS_W = 8 * MiB, W_LAYER = 93 * MiB;
constexpr size_t WO_IN = 0, WO_OUT = 20 * MiB, WO_UP = 28 * MiB, WO_DOWN = 60 * MiB, WO_GLR = 92 * MiB;
constexpr size_t WS_P = 384 * MiB;
constexpr size_t WS_CONCAT = 544 * MiB;
constexpr size_t WS_U = 608 * MiB;
constexpr size_t WS_V = 672 * MiB;
constexpr size_t WS_X1 = 800 * MiB;
constexpr size_t WS_HDN = 928 * MiB;
constexpr size_t WS_END = 1184 * MiB;
static_assert(WS_W + DEPTH * W_LAYER <= WS_P, "weights fit");
constexpr size_t WS_S = WS_U;
constexpr size_t S_XC = WS_S, S_A = WS_S + 64 * MiB, S_UU = WS_S + 128 * MiB, S_G = WS_S + 192 * MiB, S_ATT = WS_S + 224 * MiB, S_O = WS_S + 240 * MiB,
                 S_QD = WS_S + 304 * MiB, S_KI = WS_S + 336 * MiB, S_KT = WS_S + 368 * MiB, S_UPD = WS_S + 400 * MiB;
static_assert(S_UPD + 128 * MiB <= WS_END, "scratch fits");
constexpr int CW_TMO = 0, CW_CODE = 1, CW_BAR = 4096;

constexpr int RING_OFF = 0, RING_BYTES = 131072;
constexpr int LDSCTL_OFF = 147456 - 512, MISC_OFF = LDSCTL_OFF + 320;
constexpr int LDS_BYTES = 147456;
static_assert(MISC_OFF + 128 <= LDS_BYTES, "LDS map");
#define GAS __attribute__((address_space(1)))
#define LAS __attribute__((address_space(3)))
typedef unsigned short bf16;
typedef unsigned v4u __attribute__((ext_vector_type(4)));
typedef float f32x4 __attribute__((ext_vector_type(4)));
typedef short bf16x8 __attribute__((ext_vector_type(8)));
typedef GAS unsigned gu32;
typedef GAS unsigned long long gu64;
#define RLX_AGENT __ATOMIC_RELAXED, __HIP_MEMORY_SCOPE_AGENT
#define LDS_WAIT() asm volatile("s_waitcnt lgkmcnt(0)" ::: "memory")
#define VM_WAIT() asm volatile("s_waitcnt vmcnt(0)" ::: "memory")
__device__ __forceinline__ unsigned long long rt() { return __builtin_amdgcn_s_memrealtime(); }
__device__ __forceinline__ unsigned f2bf(float f) { unsigned u = __builtin_bit_cast(unsigned, f); return (u + 0x7fffu + ((u >> 16) & 1u)) >> 16; }
__device__ __forceinline__ unsigned pk2(float lo, float hi) { return f2bf(lo) | (f2bf(hi) << 16); }

#define XB_TMO      128
#define XB_XCNT(j)  (256  + 64 * (j))
#define XB_XSUB(j)  (1280 + 64 * (j))
#define XB_XGEN(j)  (2304 + 64 * (j))
#define XB_TOP      3328
#define XB_TOPGEN   3392
#define XCD_BAR_WORDS 3456
#define XB_SPIN_CAP (1u << 18)

__device__ __forceinline__ unsigned xb_ld(unsigned* p)              { return __hip_atomic_load(p, __ATOMIC_RELAXED, __HIP_MEMORY_SCOPE_AGENT); }
__device__ __forceinline__ unsigned xb_add(unsigned* p, unsigned v) { return __hip_atomic_fetch_add(p, v, __ATOMIC_RELAXED, __HIP_MEMORY_SCOPE_AGENT); }
__device__ __forceinline__ unsigned xb_xcc_id() { return (unsigned)__builtin_amdgcn_s_getreg((3 << 11) | 20) & 0xFu; }
#define XB_SPIN(cond, bar) do { unsigned _sp = 0; while (cond) { __builtin_amdgcn_s_sleep(1); \
    if ((++_sp & 255u) == 0u) { if (xb_ld(&(bar)[XB_TMO])) break; if (_sp > XB_SPIN_CAP) { atomicAdd(&(bar)[XB_TMO], 1u); break; } } } } while (0)

struct XcdBarrier {
    unsigned* bar; unsigned x;
    volatile LAS unsigned* st;
};

__device__ __forceinline__ XcdBarrier xcd_barrier_post(unsigned* bar, volatile LAS unsigned* st, int tid) {
    XcdBarrier b; b.bar = bar; b.x = xb_xcc_id(); b.st = st;
    if (tid == 0) (void)xb_add(&bar[XB_XCNT(b.x)], 1u);
    return b;
}
__device__ __forceinline__ void xcd_barrier_complete(unsigned* bar, unsigned x, unsigned& nloc, unsigned& nx) {
    const unsigned G = gridDim.x * gridDim.y * gridDim.z;
    unsigned sum, cnt, mine, sp = 0u;
    for (;;) {
        sum = 0u; cnt = 0u; mine = 0u;
#pragma unroll
        for (unsigned j = 0; j < 16; ++j) { const unsigned c = xb_ld(&bar[XB_XCNT(j)]); sum += c; cnt += (c > 0u) ? 1u : 0u; mine = (j == x) ? c : mine; }
        if (sum == G) break;
        __builtin_amdgcn_s_sleep(1);
        if ((++sp & 255u) == 0u) { if (xb_ld(&bar[XB_TMO])) break; if (sp > XB_SPIN_CAP) { atomicAdd(&bar[XB_TMO], 1u); break; } }
    }
    nloc = mine > 0u ? mine : 1u; nx = cnt > 0u ? cnt : 1u;
}

__device__ __forceinline__ void xcd_barrier(const XcdBarrier& b, int tid) {
    asm volatile("s_waitcnt vmcnt(0)" ::: "memory");
    __syncthreads();
    if (tid == 0) {
        unsigned* bar = b.bar; unsigned bxid = b.x; asm volatile("" : "+s"(bar), "+s"(bxid));
        __builtin_amdgcn_s_waitcnt(0);
        unsigned nloc = b.st[0], nx = b.st[1];
        if (nloc == 0u) { unsigned xx = bxid; asm volatile("" : "+s"(xx));   xcd_barrier_complete(bar, xx, nloc, nx); b.st[0] = nloc; b.st[1] = nx; }
        const unsigned old = xb_add(&bar[XB_XSUB(bxid)], 1u);
        const unsigned gen = old / nloc;
        if (old + 1u == (gen + 1u) * nloc) {
            __builtin_amdgcn_fence(__ATOMIC_RELEASE, "agent");
            asm volatile("s_waitcnt vmcnt(0)" ::: "memory");
            const unsigned og = xb_add(&bar[XB_TOP], 1u);
            const unsigned tg = og / nx;
            if (og + 1u == (tg + 1u) * nx) xb_add(&bar[XB_TOPGEN], 1u);
            else XB_SPIN(xb_ld(&bar[XB_TOPGEN]) == tg, bar);
            __builtin_amdgcn_fence(__ATOMIC_ACQUIRE, "agent");
            xb_add(&bar[XB_XGEN(bxid)], 1u);
            asm volatile("s_waitcnt vmcnt(0)" ::: "memory");
        } else {
            XB_SPIN(xb_ld(&bar[XB_XGEN(bxid)]) == gen, bar);
            __builtin_amdgcn_fence(__ATOMIC_ACQUIRE, "agent");
            asm volatile("s_waitcnt vmcnt(0)" ::: "memory");
        }
    }
    __syncthreads();
}


__device__ __forceinline__ float bf2f(bf16 b) { return __uint_as_float(((unsigned)b) << 16); }
__device__ __forceinline__ float wave_sum(float v) {
#pragma unroll
    for (int o = 1; o < 64; o <<= 1) v += __shfl_xor(v, o);
    return v;
}
__device__ __forceinline__ float sigmoidf_(float x) { return 1.0f / (1.0f + expf(-x)); }
__device__ __forceinline__ float softplusf_(float x) { return fmaxf(x, 0.f) + log1pf(expf(-fabsf(x))); }
__device__ __forceinline__ float gelu_tanh_(float x) { return 0.5f * x * (1.0f + tanhf(0.7978845608028654f * (x + 0.044715f * x * x * x))); }
__device__ __forceinline__ float siluf_(float x) { return x / (1.0f + expf(-x)); }

__device__ __forceinline__ void p0_transpose_item(const float* W, int K, int N, bf16* WT, LAS float* scr, int item, int lane) {
    const int nblk = N / 32, kb = item / nblk, nb = item % nblk, k0 = 64 * kb, n0 = 32 * nb;
#pragma unroll 8
    for (int i = 0; i < 32; ++i) { const int kk = 2 * i + (lane >> 5); scr[kk * 33 + (lane & 31)] = W[(size_t)(k0 + kk) * N + n0 + (lane & 31)]; }
    LDS_WAIT(); asm volatile("" ::: "memory");
    const int c = lane & 7;
#pragma unroll
    for (int j = 0; j < 4; ++j) { const int n = (lane >> 3) + 8 * j; const LAS float* s = scr + (8 * c) * 33 + n;
        v4u o; o.x = pk2(s[0 * 33], s[1 * 33]); o.y = pk2(s[2 * 33], s[3 * 33]); o.z = pk2(s[4 * 33], s[5 * 33]); o.w = pk2(s[6 * 33], s[7 * 33]);
        *(GAS v4u*)(WT + (size_t)(n0 + n) * K + k0 + 8 * c) = o; }
    LDS_WAIT(); asm volatile("" ::: "memory");
}

__device__ __forceinline__ void mod_phase(const float* c, const float* w_ada, const float* b_ada, float* MOD, LAS unsigned char* lds, int vcu, int G, int tid) {
    LAS float* cact = (LAS float*)lds;
    LAS float* red = (LAS float*)(lds + 32768);
    for (int i = tid; i < BATCH * D; i += 512) { const float x = c[i]; cact[i] = x / (1.0f + expf(-x)); }
    __syncthreads();
    const int wave = tid >> 6, lane = tid & 63;
    constexpr int NBLK = NMOD / 256;
    for (int unit = vcu; unit < DEPTH * NBLK; unit += G) {
        const int l = unit / NBLK, nb = unit % NBLK;
        const float* wp = w_ada + (size_t)l * D * NMOD + (size_t)(wave * 256) * NMOD + nb * 256 + lane * 4;
        f32x4 acc[4];
#pragma unroll
        for (int b = 0; b < 4; ++b) acc[b] = (f32x4){0.f, 0.f, 0.f, 0.f};
#pragma unroll 8
        for (int k = 0; k < 256; ++k) {
            const f32x4 w = *(const GAS f32x4*)(wp + (size_t)k * NMOD);
#pragma unroll
            for (int b = 0; b < 4; ++b) acc[b] += w * cact[b * D + wave * 256 + k];
        }
#pragma unroll
        for (int b = 0; b < 4; ++b) *(LAS f32x4*)(red + (wave * 4 + b) * 256 + lane * 4) = acc[b];
        __syncthreads();
        for (int o = tid; o < 4 * 256; o += 512) { const int b = o >> 8, n = o & 255; float s = b_ada[(size_t)l * NMOD + nb * 256 + n];
#pragma unroll
            for (int w = 0; w < 8; ++w) s += red[(w * 4 + b) * 256 + n];
            MOD[((size_t)l * BATCH + b) * NMOD + nb * 256 + n] = s; }
        __syncthreads();
    }
}

__device__ __forceinline__ void modulate_rows(const float* x, const float* sh, const float* sc, bf16* U, int gw, int NGW, int lane) {
    for (int m = gw; m < M; m += NGW) {
        const int b = m / SEQ; const GAS f32x4* xr = (const GAS f32x4*)(x + (size_t)m * D) + lane;
        const GAS f32x4* shp = (const GAS f32x4*)(sh + (size_t)b * NMOD) + lane; const GAS f32x4* scp = (const GAS f32x4*)(sc + (size_t)b * NMOD) + lane;
        GAS unsigned long long* o8 = (GAS unsigned long long*)(U + (size_t)m * D) + lane;
#pragma unroll
        for (int j = 0; j < 8; ++j) { const f32x4 v = xr[64 * j], s = scp[64 * j], h = shp[64 * j]; const f32x4 u = v * (s + 1.0f) + h;
            o8[64 * j] = (unsigned long long)pk2(u.x, u.y) | ((unsigned long long)pk2(u.z, u.w) << 32); }
    }
}
__device__ __forceinline__ void ln_rows(const float* V, const float* g, const float* bta, float* Xo, const float* sh, const float* sc, bf16* U, int gw, int NGW, int lane) {
    for (int m = gw; m < M; m += NGW) {
        const GAS f32x4* vr = (const GAS f32x4*)(V + (size_t)m * D) + lane;
        f32x4 v[8]; float s = 0.f;
#pragma unroll
        for (int j = 0; j < 8; ++j) { v[j] = vr[64 * j]; s += (v[j].x + v[j].y) + (v[j].z + v[j].w); }
        const float mean = wave_sum(s) * (1.f / D); float s2 = 0.f;
#pragma unroll
        for (int j = 0; j < 8; ++j) { v[j] = v[j] - mean; s2 += (v[j].x * v[j].x + v[j].y * v[j].y) + (v[j].z * v[j].z + v[j].w * v[j].w); }
        const float rstd = 1.f / sqrtf(wave_sum(s2) * (1.f / D) + LN_EPS);
        GAS f32x4* xo = (GAS f32x4*)(Xo + (size_t)m * D) + lane;
        const GAS f32x4* gp = (const GAS f32x4*)g + lane; const GAS f32x4* bp = (const GAS f32x4*)bta + lane;
#pragma unroll
        for (int j = 0; j < 8; ++j) { v[j] = v[j] * rstd * gp[64 * j] + bp[64 * j]; xo[64 * j] = v[j]; }
        if (U) { const int b = m / SEQ;
            const GAS f32x4* shp = (const GAS f32x4*)(sh + (size_t)b * NMOD) + lane; const GAS f32x4* scp = (const GAS f32x4*)(sc + (size_t)b * NMOD) + lane;
            GAS unsigned long long* o8 = (GAS unsigned long long*)(U + (size_t)m * D) + lane;
#pragma unroll
            for (int j = 0; j < 8; ++j) { const f32x4 u = v[j] * (scp[64 * j] + 1.0f) + shp[64 * j];
                o8[64 * j] = (unsigned long long)pk2(u.x, u.y) | ((unsigned long long)pk2(u.z, u.w) << 32); } }
    }
}
__device__ __forceinline__ void glr_mfma(const bf16* U, const bf16* Wg, float* GLR, LAS unsigned char* L, int tid, int vcu, int G) {
    const int lane = tid & 63, wave = __builtin_amdgcn_readfirstlane(tid >> 6), rb = wave & 3, kh = wave >> 2, fr = lane & 15, fq = lane >> 4;
    for (int blk = vcu; blk < M / 64; blk += G) {
        const GAS v4u* ap = (const GAS v4u*)(U + (size_t)(blk * 64 + rb * 16 + fr) * D + kh * 1024 + 8 * fq);
        const GAS v4u* bp = (const GAS v4u*)(Wg + (size_t)fr * D + kh * 1024 + 8 * fq);
        f32x4 c = {0.f, 0.f, 0.f, 0.f};
#pragma unroll 1
        for (int kb = 0; kb < 4; ++kb) { v4u a[8], b[8];
#pragma unroll
            for (int ks = 0; ks < 8; ++ks) { a[ks] = ap[(kb * 8 + ks) * 4]; b[ks] = bp[(kb * 8 + ks) * 4]; }
#pragma unroll
            for (int ks = 0; ks < 8; ++ks) c = __builtin_amdgcn_mfma_f32_16x16x32_bf16(__builtin_bit_cast(bf16x8, a[ks]), __builtin_bit_cast(bf16x8, b[ks]), c, 0, 0, 0); }
        if (kh == 1) *(LAS f32x4*)(L + (rb * 64 + lane) * 16) = c;
        asm volatile("s_waitcnt lgkmcnt(0)" ::: "memory"); __builtin_amdgcn_s_barrier(); asm volatile("" ::: "memory");
        if (kh == 0) { const f32x4 o = *(const LAS f32x4*)(L + (rb * 64 + lane) * 16) + c; float* gp = GLR + (size_t)(blk * 64 + rb * 16 + fq * 4) * GLA_RANK + fr;
            gp[0] = o.x; gp[GLA_RANK] = o.y; gp[2 * GLA_RANK] = o.z; gp[3 * GLA_RANK] = o.w; }
        asm volatile("s_waitcnt lgkmcnt(0)" ::: "memory"); __builtin_amdgcn_s_barrier(); asm volatile("" ::: "memory");
    }
}

typedef __bf16 bf16x2_t __attribute__((ext_vector_type(2)));
typedef float f32x2_t __attribute__((ext_vector_type(2)));
typedef float f32x16 __attribute__((ext_vector_type(16)));
typedef short s16x4 __attribute__((ext_vector_type(4)));
__device__ __forceinline__ unsigned cvtpk(float lo, float hi) { f32x2_t v = {lo, hi}; bf16x2_t b = __builtin_convertvector(v, bf16x2_t); return __builtin_bit_cast(unsigned, b); }
__device__ __forceinline__ float blo(unsigned w) { return __uint_as_float(w << 16); }
__device__ __forceinline__ float bhi(unsigned w) { return __uint_as_float(w & 0xffff0000u); }
__device__ __forceinline__ float fexp(float x) { return __builtin_amdgcn_exp2f(x * 1.4426950408889634f); }
__device__ __forceinline__ float frcp(float x) { return __builtin_amdgcn_rcpf(x); }
__device__ __forceinline__ float fsigmoid(float x) { return frcp(1.0f + fexp(-x)); }
__device__ __forceinline__ float fgelu_tanh(float x) { const float y = 0.7978845608028654f * (x + 0.044715f * x * x * x); const float t = 1.0f - 2.0f * frcp(fexp(2.0f * y) + 1.0f); return 0.5f * x * (1.0f + t); }
__device__ __forceinline__ float fsilu(float x) { return x * frcp(1.0f + fexp(-x)); }
__device__ __forceinline__ float neg_expm1(float x) {
    const float p = x * (1.0f + x * (0.5f + x * (0.16666667f + x * (0.041666668f + x * 0.0083333338f))));
    const float e = fexp(x) - 1.0f; return -(x > -0.1f ? p : e);
}
#define WG_BAR() do { asm volatile("s_waitcnt vmcnt(0) lgkmcnt(0)" ::: "memory"); __builtin_amdgcn_s_barrier(); asm volatile("" ::: "memory"); } while (0)

constexpr int RG_SEGS = 8, RG_SEG_T = SEQ / RG_SEGS, RG_TT = 64;
constexpr int RG_XCB = 0, RG_XS = 272;
constexpr int RG_AS = RG_XCB + 64 * RG_XS, RG_FS = 132;
constexpr int RG_US = RG_AS + 64 * RG_FS * 4;
constexpr int RG_AGG = RG_US + 64 * RG_FS * 4;
constexpr int RG_CW = RG_AGG + 4 * 128 * 2 * 4;
constexpr int RG_END = RG_CW + 5 * 128 * 4;
static_assert(RG_END <= RING_BYTES, "RG LDS map");

template <bool PASS2>
__device__ __forceinline__ void rg_unit(LAS unsigned char* L, int tid, int unit, const bf16* P, const float* cw, const float* cb, const float* wa, const float* ba, const float* wx, const float* bx,
                                        const float* lam, float* AGG, bf16* CC) {
    const int wave = __builtin_amdgcn_readfirstlane(tid >> 6);
    const int b = unit >> 6, h = (unit >> 3) & 7, s = unit & 7;
    const int jc0 = 16 * wave + (tid & 15), kq0 = (tid & 63) >> 4;
    bf16x8 Ba[4], Bx[4];
    { const float* wap = wa + (size_t)h * RG_BW * RG_BW + jc0; const float* wxp = wx + (size_t)h * RG_BW * RG_BW + jc0;
#pragma unroll
      for (int ks = 0; ks < 4; ++ks) { v4u pa, px;
#pragma unroll
        for (int e2 = 0; e2 < 4; ++e2) { const int i0 = 32 * ks + 8 * kq0 + 2 * e2;
            pa[e2] = cvtpk(wap[(size_t)i0 * RG_BW], wap[(size_t)(i0 + 1) * RG_BW]); px[e2] = cvtpk(wxp[(size_t)i0 * RG_BW], wxp[(size_t)(i0 + 1) * RG_BW]); }
        Ba[ks] = __builtin_bit_cast(bf16x8, pa); Bx[ks] = __builtin_bit_cast(bf16x8, px); } }
    const float bja = ba[h * RG_BW + jc0], bjx = bx[h * RG_BW + jc0];
    float spj; { const float nl = -lam[h * RG_BW + jc0]; spj = RG_C * (fmaxf(nl, 0.f) + log1pf(expf(-fabsf(nl)))); }
    LAS float* CW = (LAS float*)(L + RG_CW);
    CW[tid] = cw[(tid >> 7) * D_RG + h * RG_BW + (tid & 127)];
    if (tid < 128) CW[512 + tid] = cb[h * RG_BW + tid];
    const int ch0 = tid & 127;
    float carryA = 1.0f, carryH = 0.0f;
    if (PASS2) { for (int j = 0; j < s; ++j) { const f32x2_t ah = *(const f32x2_t*)(AGG + ((size_t)(b * RG_SEGS + j) * D_RG + h * RG_BW + ch0) * 2); carryH = ah.x * carryH + ah.y; } }
    WG_BAR();
#pragma unroll 1
    for (int st = 0; st < RG_SEG_T / RG_TT; ++st) {
        int t2 = tid; asm volatile("" : "+v"(t2));
        const int lane = t2 & 63, kq = lane >> 4, jc = 16 * wave + (lane & 15), ch = t2 & 127, q = t2 >> 7, tok = t2 >> 3, c0 = 16 * (t2 & 7);
        LAS float* AS = (LAS float*)(L + RG_AS); LAS float* US = (LAS float*)(L + RG_US); LAS f32x2_t* AG = (LAS f32x2_t*)(L + RG_AGG);
        const int t0 = s * RG_SEG_T + st * RG_TT; const size_t m0 = (size_t)b * SEQ + t0;
        { float xc[16];
#pragma unroll
          for (int e = 0; e < 16; ++e) xc[e] = CW[512 + c0 + e];
#pragma unroll
          for (int jj = 0; jj < 4; ++jj) { const int tt = t0 + tok - 3 + jj;
            if (tt >= 0) { const GAS v4u* xp = (const GAS v4u*)(P + (m0 + tok - 3 + jj) * NP + C_RGX + h * RG_BW + c0); const v4u x0 = xp[0], x1 = xp[1];
                const unsigned xw[8] = {x0.x, x0.y, x0.z, x0.w, x1.x, x1.y, x1.z, x1.w};
#pragma unroll
                for (int e2 = 0; e2 < 8; ++e2) { xc[2 * e2] += CW[jj * 128 + c0 + 2 * e2] * blo(xw[e2]); xc[2 * e2 + 1] += CW[jj * 128 + c0 + 2 * e2 + 1] * bhi(xw[e2]); } } }
          v4u o0, o1; o0.x = cvtpk(xc[0], xc[1]); o0.y = cvtpk(xc[2], xc[3]); o0.z = cvtpk(xc[4], xc[5]); o0.w = cvtpk(xc[6], xc[7]);
          o1.x = cvtpk(xc[8], xc[9]); o1.y = cvtpk(xc[10], xc[11]); o1.z = cvtpk(xc[12], xc[13]); o1.w = cvtpk(xc[14], xc[15]);
          LAS v4u* xo = (LAS v4u*)(L + RG_XCB + tok * RG_XS + c0 * 2); xo[0] = o0; xo[1] = o1; }
        WG_BAR();
        {
#pragma unroll
          for (int rb = 0; rb < 4; ++rb) { f32x4 ca = {0.f, 0.f, 0.f, 0.f}, cx = {0.f, 0.f, 0.f, 0.f};
#pragma unroll
            for (int ks = 0; ks < 4; ++ks) { const bf16x8 A = *(const LAS bf16x8*)(L + RG_XCB + (rb * 16 + (lane & 15)) * RG_XS + (ks * 32 + 8 * kq) * 2);
                ca = __builtin_amdgcn_mfma_f32_16x16x32_bf16(A, Ba[ks], ca, 0, 0, 0); cx = __builtin_amdgcn_mfma_f32_16x16x32_bf16(A, Bx[ks], cx, 0, 0, 0); }
#pragma unroll
            for (int r = 0; r < 4; ++r) { const int tk = rb * 16 + kq * 4 + r;
                const float rg = fsigmoid(ca[r] + bja), ig = fsigmoid(cx[r] + bjx), la = -rg * spj, a = fexp(la), m2 = neg_expm1(2.0f * la);
                const float xcv = bf2f(*(const LAS bf16*)(L + RG_XCB + tk * RG_XS + jc * 2));
                AS[tk * RG_FS + jc] = a; US[tk * RG_FS + jc] = sqrtf(m2) * ig * xcv; } } }
        WG_BAR();
        { float av[16], uv[16];
#pragma unroll
          for (int i = 0; i < 16; ++i) { av[i] = AS[(q * 16 + i) * RG_FS + ch]; uv[i] = US[(q * 16 + i) * RG_FS + ch]; }
          float ap = 1.0f, hp = 0.0f;
#pragma unroll
          for (int i = 0; i < 16; ++i) { ap *= av[i]; hp = av[i] * hp + uv[i]; }
          AG[q * 128 + ch] = (f32x2_t){ap, hp};
          WG_BAR();
          const f32x2_t g0 = AG[ch], g1 = AG[128 + ch], g2 = AG[256 + ch], g3 = AG[384 + ch];
          const float c1 = g0.x * carryH + g0.y, c2 = g1.x * c1 + g1.y, c3 = g2.x * c2 + g2.y, c4 = g3.x * c3 + g3.y;
          if (PASS2) { float hh = q == 0 ? carryH : (q == 1 ? c1 : (q == 2 ? c2 : c3));
#pragma unroll
            for (int i = 0; i < 16; ++i) { hh = av[i] * hh + uv[i]; US[(q * 16 + i) * RG_FS + ch] = hh; } }
          else carryA *= (g0.x * g1.x) * (g2.x * g3.x);
          carryH = c4; }
        if (PASS2) {
            WG_BAR();
            const GAS v4u* gp = (const GAS v4u*)(P + (m0 + tok) * NP + C_RGG + h * RG_BW + c0); const v4u g0 = gp[0], g1 = gp[1];
            const unsigned gw_[8] = {g0.x, g0.y, g0.z, g0.w, g1.x, g1.y, g1.z, g1.w};
            const LAS f32x4* hp4 = (const LAS f32x4*)(L + RG_US + (tok * RG_FS + c0) * 4);
            unsigned ow[8];
#pragma unroll
            for (int e4 = 0; e4 < 4; ++e4) { const f32x4 hv = hp4[e4];
                ow[2 * e4] = cvtpk(hv.x * fgelu_tanh(blo(gw_[2 * e4])), hv.y * fgelu_tanh(bhi(gw_[2 * e4])));
                ow[2 * e4 + 1] = cvtpk(hv.z * fgelu_tanh(blo(gw_[2 * e4 + 1])), hv.w * fgelu_tanh(bhi(gw_[2 * e4 + 1]))); }
            GAS v4u* op = (GAS v4u*)(CC + (m0 + tok) * D + h * RG_BW + c0);
            op[0] = (v4u){ow[0], ow[1], ow[2], ow[3]}; op[1] = (v4u){ow[4], ow[5], ow[6], ow[7]};
        }
    }
    if (!PASS2 && (tid >> 7) == 0) *(f32x2_t*)(AGG + ((size_t)(b * RG_SEGS + s) * D_RG + h * RG_BW + ch0) * 2) = (f32x2_t){carryA, carryH};
    WG_BAR();
}

constexpr int GLA_SEGS = 16, GLA_SEG_CH = NCHUNK / GLA_SEGS;
constexpr int GL_GS = 0, GL_GSTR = 132;
constexpr int GL_QD = GL_GS + 64 * GL_GSTR * 4, GL_QS = 272;
constexpr int GL_KI = GL_QD + 64 * GL_QS;
constexpr int GL_OS = 0, GL_OSTR = 260;
constexpr int GL_KT = GL_KI + 64 * GL_QS, GL_KTS = 320;
constexpr int GL_VS = GL_KT + 64 * GL_KTS, GL_VSS = 576;
constexpr int GL_ATT = GL_VS + 64 * GL_VSS, GL_ATS = 144;
constexpr int GL_TOT = GL_ATT + 64 * GL_ATS;
constexpr int GL_BL = GL_TOT + 2048, GL_DEC = GL_BL + 512, GL_NG = GL_DEC + 512;
constexpr int GL_END = GL_NG + 1024;
static_assert(64 * GL_OSTR * 4 <= GL_KT && GL_END <= LDSCTL_OFF, "GLA LDS map");
typedef short v4i16_t __attribute__((ext_vector_type(4)));
__device__ __forceinline__ s16x4 tr_read(const LAS unsigned char* p) { return __builtin_bit_cast(s16x4, __builtin_amdgcn_ds_read_tr16_b64_v4i16((LAS v4i16_t*)p)); }
__device__ __forceinline__ int crow(int reg, int hh) { return (reg & 3) + 8 * (reg >> 2) + 4 * hh; }
__device__ __forceinline__ f32x16 zero16() { return (f32x16){0.f, 0.f, 0.f, 0.f, 0.f, 0.f, 0.f, 0.f, 0.f, 0.f, 0.f, 0.f, 0.f, 0.f, 0.f, 0.f}; }
#define MFMA32(a, b, c) __builtin_amdgcn_mfma_f32_32x32x16_bf16((a), (b), (c), 0, 0, 0)

template <bool PASS2>
__device__ __forceinline__ void gla_unit(LAS unsigned char* L, int tid, int unit, const bf16* P, const float* GLR, const float* wg2, const float* bg2, const float* ng, float* SLOC, float* DSEG, bf16* CC) {
    const int wave = __builtin_amdgcn_readfirstlane(tid >> 6);
    const int zib = wave >> 2, zjb = wave & 3;
    const int b = unit >> 6, h = (unit >> 4) & 3, g = unit & 15;
    const size_t mbase = (size_t)b * SEQ + (size_t)g * (GLA_SEG_CH * CHUNK);
    const int lane0 = tid & 63, hh0 = lane0 >> 5, l310 = lane0 & 31;
    float bw[8];
#pragma unroll
    for (int s = 0; s < 8; ++s) bw[s] = wg2[(size_t)(2 * s + hh0) * GLA_DK + h * HK + 32 * zjb + l310];
    const float bgz = bg2[h * HK + 32 * zjb + l310];
    LAS float* GS = (LAS float*)(L + GL_GS); LAS float* TOT = (LAS float*)(L + GL_TOT); LAS float* BL = (LAS float*)(L + GL_BL); LAS float* DEC = (LAS float*)(L + GL_DEC); LAS float* NGL = (LAS float*)(L + GL_NG);
    if (PASS2 && tid < HV) NGL[tid] = ng[h * HV + tid];
    f32x16 S[4];
    float* sl = SLOC + ((size_t)unit * 8 + wave) * 4096;
#pragma unroll
    for (int db = 0; db < 4; ++db)
#pragma unroll
        for (int g4 = 0; g4 < 4; ++g4) { f32x4 v = {0.f, 0.f, 0.f, 0.f}; if (PASS2) v = *(const GAS f32x4*)(sl + ((db * 4 + g4) * 64 + lane0) * 4);
            S[db][4 * g4] = v.x; S[db][4 * g4 + 1] = v.y; S[db][4 * g4 + 2] = v.z; S[db][4 * g4 + 3] = v.w; }
    float segl = 0.f;
#pragma unroll 1
    for (int n = 0; n < GLA_SEG_CH; ++n) {
        int t2 = tid; asm volatile("" : "+v"(t2));
        const int lane = t2 & 63, hh = lane >> 5, l31 = lane & 31;
        const int tok = t2 >> 3, cg = t2 & 7, d0 = 16 * cg;
        const int sd = t2 & 127, sq = t2 >> 7;
        const int blk = (lane >> 4) & 1, qq = (lane & 15) >> 2, pp = lane & 3;
        const size_t m0 = mbase + (size_t)n * CHUNK;
        { const GAS float* gp = (const GAS float*)(GLR + (m0 + 32 * zib + l31) * GLA_RANK) + hh; float ar[8];
#pragma unroll
          for (int s = 0; s < 8; ++s) ar[s] = gp[2 * s];
          f32x16 z = zero16();
#pragma unroll
          for (int s = 0; s < 8; ++s) z = __builtin_amdgcn_mfma_f32_32x32x2f32(ar[s], bw[s], z, 0, 0, 0);
#pragma unroll
          for (int r = 0; r < 16; ++r) { const float zz = z[r] + bgz; const float sp = fmaxf(-zz, 0.f) + 0.6931471805599453f * __builtin_amdgcn_logf(1.0f + fexp(-fabsf(zz)));
              GS[(32 * zib + crow(r, hh)) * GL_GSTR + 32 * zjb + l31] = sp * (-1.0f / GLA_TAU); } }
        WG_BAR();
        { float p[16]; float run = 0.f;
#pragma unroll
          for (int i = 0; i < 16; ++i) { run += GS[(16 * sq + i) * GL_GSTR + sd]; p[i] = run; }
          TOT[sq * 128 + sd] = run;
          WG_BAR();
          const float t0 = TOT[sd], t1 = TOT[128 + sd], t2 = TOT[256 + sd], t3 = TOT[384 + sd];
          const float off = sq == 0 ? 0.f : (sq == 1 ? t0 : (sq == 2 ? t0 + t1 : (t0 + t1) + t2));
#pragma unroll
          for (int i = 0; i < 16; ++i) GS[(16 * sq + i) * GL_GSTR + sd] = p[i] + off;
          if (sq == 0) { const float tot = ((t0 + t1) + t2) + t3; BL[sd] = tot; DEC[sd] = fexp(tot); segl += tot; } }
        WG_BAR();
        { const GAS v4u* kp = (const GAS v4u*)(P + (m0 + tok) * NP + C_K + h * HK + d0); const v4u k0 = kp[0], k1 = kp[1];
          const unsigned kw[8] = {k0.x, k0.y, k0.z, k0.w, k1.x, k1.y, k1.z, k1.w};
          unsigned qw[8];
          if (PASS2) { const GAS v4u* qp = (const GAS v4u*)(P + (m0 + tok) * NP + C_Q + h * HK + d0); const v4u q0 = qp[0], q1 = qp[1];
              qw[0] = q0.x; qw[1] = q0.y; qw[2] = q0.z; qw[3] = q0.w; qw[4] = q1.x; qw[5] = q1.y; qw[6] = q1.z; qw[7] = q1.w; }
          unsigned oq[8], oi[8], ot[8];
#pragma unroll
          for (int e4 = 0; e4 < 4; ++e4) { const f32x4 bc = *(const LAS f32x4*)(L + GL_GS + (tok * GL_GSTR + d0 + 4 * e4) * 4); const f32x4 bl = *(const LAS f32x4*)(L + GL_BL + (d0 + 4 * e4) * 4);
#pragma unroll
              for (int w2 = 0; w2 < 2; ++w2) { const float b0 = w2 ? bc.z : bc.x, b1 = w2 ? bc.w : bc.y, l0 = w2 ? bl.z : bl.x, l1 = w2 ? bl.w : bl.y;
                  const float kx = blo(kw[2 * e4 + w2]), ky = bhi(kw[2 * e4 + w2]);
                  ot[2 * e4 + w2] = cvtpk(kx * fexp(l0 - b0), ky * fexp(l1 - b1));
                  if (PASS2) { const float qx = blo(qw[2 * e4 + w2]), qy = bhi(qw[2 * e4 + w2]);
                      oq[2 * e4 + w2] = cvtpk(qx * QSCALE * fexp(b0), qy * QSCALE * fexp(b1)); oi[2 * e4 + w2] = cvtpk(kx * fexp(-b0), ky * fexp(-b1)); } } }
          LAS v4u* tp = (LAS v4u*)(L + GL_KT + tok * GL_KTS + d0 * 2); tp[0] = (v4u){ot[0], ot[1], ot[2], ot[3]}; tp[1] = (v4u){ot[4], ot[5], ot[6], ot[7]};
          if (PASS2) { LAS v4u* qo = (LAS v4u*)(L + GL_QD + tok * GL_QS + d0 * 2); qo[0] = (v4u){oq[0], oq[1], oq[2], oq[3]}; qo[1] = (v4u){oq[4], oq[5], oq[6], oq[7]};
                       LAS v4u* io = (LAS v4u*)(L + GL_KI + tok * GL_QS + d0 * 2); io[0] = (v4u){oi[0], oi[1], oi[2], oi[3]}; io[1] = (v4u){oi[4], oi[5], oi[6], oi[7]}; }
#pragma unroll
          for (int i = 0; i < 4; ++i) { const int c = tid + 512 * i, row = c >> 5, chk = c & 31;
              *(LAS v4u*)(L + GL_VS + row * GL_VSS + chk * 16) = *(const GAS v4u*)(P + (m0 + row) * NP + C_V + h * HV + chk * 8); } }
        WG_BAR();
        f32x16 o[2];
        if (PASS2) {
            if (wave < 3) { const int jb = wave == 2, ib = wave >= 1; f32x16 c = zero16();
#pragma unroll
                for (int ks = 0; ks < 8; ++ks) { const bf16x8 A = *(const LAS bf16x8*)(L + GL_KI + (32 * jb + l31) * GL_QS + (16 * ks + 8 * hh) * 2);
                    const bf16x8 B = *(const LAS bf16x8*)(L + GL_QD + (32 * ib + l31) * GL_QS + (16 * ks + 8 * hh) * 2); c = MFMA32(A, B, c); }
                const int icol = 32 * ib + l31;
#pragma unroll
                for (int g4 = 0; g4 < 4; ++g4) { const int j0 = 32 * jb + 8 * g4 + 4 * hh;
                    const float c0 = (j0 + 0 <= icol) ? c[4 * g4] : 0.f, c1 = (j0 + 1 <= icol) ? c[4 * g4 + 1] : 0.f, c2 = (j0 + 2 <= icol) ? c[4 * g4 + 2] : 0.f, c3 = (j0 + 3 <= icol) ? c[4 * g4 + 3] : 0.f;
                    *(LAS f32x2_t*)(L + GL_ATT + icol * GL_ATS + j0 * 2) = __builtin_bit_cast(f32x2_t, (unsigned long long)cvtpk(c0, c1) | ((unsigned long long)cvtpk(c2, c3) << 32)); } }
            o[0] = zero16(); o[1] = zero16();
#pragma unroll
            for (int db = 0; db < 4; ++db)
#pragma unroll
                for (int s = 0; s < 2; ++s) { v4u pk; pk.x = cvtpk(S[db][8 * s], S[db][8 * s + 1]); pk.y = cvtpk(S[db][8 * s + 2], S[db][8 * s + 3]); pk.z = cvtpk(S[db][8 * s + 4], S[db][8 * s + 5]); pk.w = cvtpk(S[db][8 * s + 6], S[db][8 * s + 7]);
                    const bf16x8 Bf = __builtin_bit_cast(bf16x8, pk);
#pragma unroll
                    for (int ib = 0; ib < 2; ++ib) { const LAS unsigned char* qr = L + GL_QD + (32 * ib + l31) * GL_QS + (32 * db + 16 * s + 4 * hh) * 2;
                        const s16x4 lo = *(const LAS s16x4*)qr, hi = *(const LAS s16x4*)(qr + 16);
                        const bf16x8 Af = __builtin_shufflevector(lo, hi, 0, 1, 2, 3, 4, 5, 6, 7); o[ib] = MFMA32(Af, Bf, o[ib]); } }
            WG_BAR();
        }
        { bf16x8 vf[4];
#pragma unroll
          for (int ks = 0; ks < 4; ++ks) { const LAS unsigned char* vp = L + GL_VS + (16 * ks + 8 * hh + qq) * GL_VSS + (32 * wave + 16 * blk + 4 * pp) * 2;
              const s16x4 lo = tr_read(vp), hi = tr_read(vp + 4 * GL_VSS); vf[ks] = __builtin_shufflevector(lo, hi, 0, 1, 2, 3, 4, 5, 6, 7); }
          if (PASS2) {
#pragma unroll
              for (int ib = 0; ib < 2; ++ib)
#pragma unroll
                  for (int ks = 0; ks < 4; ++ks) if (ks < 2 * (ib + 1)) { const bf16x8 A = *(const LAS bf16x8*)(L + GL_ATT + (32 * ib + l31) * GL_ATS + (16 * ks + 8 * hh) * 2); o[ib] = MFMA32(A, vf[ks], o[ib]); } }
#pragma unroll
          for (int db = 0; db < 4; ++db) {
#pragma unroll
              for (int g4 = 0; g4 < 4; ++g4) { const f32x4 dv = *(const LAS f32x4*)(L + GL_DEC + (32 * db + 8 * g4 + 4 * hh) * 4);
                  S[db][4 * g4] *= dv.x; S[db][4 * g4 + 1] *= dv.y; S[db][4 * g4 + 2] *= dv.z; S[db][4 * g4 + 3] *= dv.w; }
#pragma unroll
              for (int ks = 0; ks < 4; ++ks) { const LAS unsigned char* kp = L + GL_KT + (16 * ks + 8 * hh + qq) * GL_KTS + (32 * db + 16 * blk + 4 * pp) * 2;
                  const s16x4 lo = tr_read(kp), hi = tr_read(kp + 4 * GL_KTS); const bf16x8 Af = __builtin_shufflevector(lo, hi, 0, 1, 2, 3, 4, 5, 6, 7);
                  S[db] = MFMA32(Af, vf[ks], S[db]); } } }
        WG_BAR();
        if (PASS2) {
#pragma unroll
            for (int ib = 0; ib < 2; ++ib)
#pragma unroll
                for (int r = 0; r < 16; ++r) *(LAS float*)(L + GL_OS + ((32 * ib + crow(r, hh)) * GL_OSTR + 32 * wave + l31) * 4) = o[ib][r];
            WG_BAR();
            { const int v0 = 32 * cg; f32x4 ov[8]; float ss = 0.f;
#pragma unroll
              for (int i = 0; i < 8; ++i) { ov[i] = *(const LAS f32x4*)(L + GL_OS + (tok * GL_OSTR + v0 + 4 * i) * 4); ss += (ov[i].x * ov[i].x + ov[i].y * ov[i].y) + (ov[i].z * ov[i].z + ov[i].w * ov[i].w); }
              ss += __shfl_xor(ss, 1); ss += __shfl_xor(ss, 2); ss += __shfl_xor(ss, 4);
              const float rs = 1.0f / sqrtf(ss * (1.0f / HV) + LN_EPS);
              const GAS v4u* rp = (const GAS v4u*)(P + (m0 + tok) * NP + C_R + h * HV + v0); GAS v4u* op = (GAS v4u*)(CC + (m0 + tok) * D + D_RG + h * HV + v0);
#pragma unroll
              for (int i = 0; i < 4; ++i) { const v4u rw = rp[i]; const f32x4 n0 = *(const LAS f32x4*)(L + GL_NG + (v0 + 8 * i) * 4), n1 = *(const LAS f32x4*)(L + GL_NG + (v0 + 8 * i + 4) * 4);
                  const f32x4 a0 = ov[2 * i], a1 = ov[2 * i + 1]; v4u w;
                  w.x = cvtpk(a0.x * rs * n0.x * fsilu(blo(rw.x)), a0.y * rs * n0.y * fsilu(bhi(rw.x))); w.y = cvtpk(a0.z * rs * n0.z * fsilu(blo(rw.y)), a0.w * rs * n0.w * fsilu(bhi(rw.y)));
                  w.z = cvtpk(a1.x * rs * n1.x * fsilu(blo(rw.z)), a1.y * rs * n1.y * fsilu(bhi(rw.z))); w.w = cvtpk(a1.z * rs * n1.z * fsilu(blo(rw.w)), a1.w * rs * n1.w * fsilu(bhi(rw.w)));
                  op[i] = w; } }
            WG_BAR();
        }
    }
    if (!PASS2) {
#pragma unroll
        for (int db = 0; db < 4; ++db)
#pragma unroll
            for (int g4 = 0; g4 < 4; ++g4) *(GAS f32x4*)(sl + ((db * 4 + g4) * 64 + lane0) * 4) = (f32x4){S[db][4 * g4], S[db][4 * g4 + 1], S[db][4 * g4 + 2], S[db][4 * g4 + 3]};
        if ((tid >> 7) == 0) DSEG[(size_t)unit * HK + (tid & 127)] = fexp(segl);
    }
    WG_BAR();
}
__device__ __forceinline__ void gla_prefix(float* SLOC, const float* DSEG, size_t gt, size_t NT) {
    for (size_t i = gt; i < (size_t)BATCH * GLA_H * 8192; i += NT) { const int bh = (int)(i >> 13), e4 = (int)(i & 8191), lane = e4 & 63, g4 = (e4 >> 6) & 3, db = (e4 >> 8) & 3;
        const int d = 32 * db + 8 * g4 + 4 * (lane >> 5);
        f32x4 x[GLA_SEGS], dv[GLA_SEGS];
#pragma unroll
        for (int g = 0; g < GLA_SEGS; ++g) { x[g] = *(const GAS f32x4*)(SLOC + ((size_t)(bh * GLA_SEGS + g) * 8192 + e4) * 4); dv[g] = *(const GAS f32x4*)(DSEG + (size_t)(bh * GLA_SEGS + g) * HK + d); }
        f32x4 s = {0.f, 0.f, 0.f, 0.f};
#pragma unroll
        for (int g = 0; g < GLA_SEGS; ++g) { *(GAS f32x4*)(SLOC + ((size_t)(bh * GLA_SEGS + g) * 8192 + e4) * 4) = s; s = dv[g] * s + x[g]; } }
}

struct Args { const float* in[24]; float* out; unsigned char* ws; int ph_lo, ph_hi; };
typedef const __attribute__((address_space(4))) unsigned char* kargp_t;
__device__ __forceinline__ const float* karg_in(int i) { kargp_t ka = (kargp_t)__builtin_amdgcn_kernarg_segment_ptr(); asm volatile("" : "+s"(ka)); return *(const float* const __attribute__((address_space(4)))*)(ka + 8 * i); }
__device__ __forceinline__ float* karg_out() { kargp_t ka = (kargp_t)__builtin_amdgcn_kernarg_segment_ptr(); asm volatile("" : "+s"(ka)); return *(float* const __attribute__((address_space(4)))*)(ka + 8 * 24); }
__device__ __forceinline__ unsigned char* karg_ws() { kargp_t ka = (kargp_t)__builtin_amdgcn_kernarg_segment_ptr(); asm volatile("" : "+s"(ka)); return *(unsigned char* const __attribute__((address_space(4)))*)(ka + 8 * 25); }
#define IN(i) karg_in(i)
__global__ void __launch_bounds__(NWAVES * 64, 2) mk_fwd(Args args) {
    extern __shared__ __attribute__((aligned(16))) unsigned char lds[];
    LAS unsigned char* const L0 = (LAS unsigned char*)lds;
    volatile LAS unsigned* const MISC = (volatile LAS unsigned*)(L0 + MISC_OFF);
    const int G0 = gridDim.x; const int bx0 = blockIdx.x; const int vcu0 = (G0 % 8 == 0) ? (bx0 % 8) * (G0 / 8) + bx0 / 8 : bx0;
    const int wave0 = __builtin_amdgcn_readfirstlane((int)threadIdx.x >> 6);
#define MK_TID() (mk_wave() * 64 + (int)__builtin_amdgcn_mbcnt_hi(~0u, __builtin_amdgcn_mbcnt_lo(~0u, 0u)))
    auto mk_wave = [&]() { int w = wave0; asm volatile("" : "+s"(w)); return w; };
    for (int u = MK_TID(); u < (LDS_BYTES - LDSCTL_OFF) / 4; u += NWAVES * 64) ((LAS unsigned*)(L0 + LDSCTL_OFF))[u] = 0u;
    __syncthreads();
    XcdBarrier bar; bar.bar = (unsigned*)(karg_ws() + WS_CTL) + CW_BAR; bar.x = 0; bar.st = nullptr;
    if (!MK_LAUNCH_PER_PHASE) bar = xcd_barrier_post((unsigned*)(karg_ws() + WS_CTL) + CW_BAR, MISC + 8, MK_TID());
#if MK_LAUNCH_PER_PHASE
    const int lo = args.ph_lo, hi = args.ph_hi; int pid = 0;
#define PH_ON() (pid >= lo && pid < hi)
#define PH_END() do { ++pid; } while (0)
#else
    (void)args;
#define PH_ON() true
#define PH_END() xcd_barrier(bar, MK_TID())
#endif
#define PH_LOCALS() int tid = MK_TID(); asm volatile("" : "+v"(tid)); const int lane = tid & 63, wave = __builtin_amdgcn_readfirstlane(tid >> 6); \
    int G = G0, bx = bx0, vcu = vcu0; asm volatile("" : "+s"(G), "+s"(bx), "+s"(vcu)); LAS unsigned char* L = L0; asm volatile("" : "+s"(L)); \
    unsigned char* const ws = karg_ws(); const int gw = vcu * NWAVES + wave, NGW = G * NWAVES; \
    const size_t gt = (size_t)vcu * (NWAVES * 64) + tid, NT = (size_t)G * (NWAVES * 64); \
    float* const MOD = (float*)(ws + WS_MOD); float* const GLR = (float*)(ws + WS_GLR); \
    bf16* const P = (bf16*)(ws + WS_P); bf16* const CC = (bf16*)(ws + WS_CONCAT); bf16* const U = (bf16*)(ws + WS_U); \
    float* const V = (float*)(ws + WS_V); float* const X1 = (float*)(ws + WS_X1); bf16* const HDN = (bf16*)(ws + WS_HDN); \
    (void)L; (void)bx; (void)lane; (void)wave; (void)gw; (void)NGW; (void)gt; (void)NT; (void)MOD; (void)GLR; (void)P; (void)CC; (void)U; (void)V; (void)X1; (void)HDN;

    for (int rep_ = 0; rep_ < REP_PRO; ++rep_) {
    if (PH_ON()) { PH_LOCALS();
        LAS float* scr = (LAS float*)(L + RING_OFF + wave * 16384);
        constexpr int I_IN = (D / 64) * (NP / 32), I_OUT = (D / 64) * (D / 32), I_UP = (D / 64) * (FF / 32), I_DOWN = (FF / 64) * (D / 32), I_L = I_IN + I_OUT + I_UP + I_DOWN;
        for (int it = gw; it < DEPTH * I_L; it += NGW) {
            const int l = it / I_L; int r = it % I_L; unsigned char* wl = ws + WS_W + (size_t)l * W_LAYER;
            if (r < I_IN) { p0_transpose_item(IN(4) + (size_t)l * D * D_IN, D, D_IN, (bf16*)(wl + WO_IN), scr, r, lane); continue; } r -= I_IN;
            if (r < I_OUT) { p0_transpose_item(IN(15) + (size_t)l * D * D, D, D, (bf16*)(wl + WO_OUT), scr, r, lane); continue; } r -= I_OUT;
            if (r < I_UP) { p0_transpose_item(IN(18) + (size_t)l * D * FF, D, FF, (bf16*)(wl + WO_UP), scr, r, lane); continue; } r -= I_UP;
            p0_transpose_item(IN(20) + (size_t)l * FF * D, FF, D, (bf16*)(wl + WO_DOWN), scr, r, lane);
        }
        { const float* w_in = IN(4);
        for (size_t i = gt; i < (size_t)DEPTH * GLA_RANK * D; i += NT) { const int l = (int)(i / (GLA_RANK * D)), j = (int)((i / D) % GLA_RANK), k = (int)(i % D);
            ((bf16*)(ws + WS_W + (size_t)l * W_LAYER + WO_GLR))[j * D + k] = (bf16)f2bf(w_in[(size_t)l * D * D_IN + (size_t)k * D_IN + C_GLR + j]); } }
        __syncthreads();
        mod_phase(IN(1), IN(2), IN(3), MOD, L, vcu, G, tid);
    }
    PH_END(); }
    if (PH_ON()) { PH_LOCALS(); modulate_rows(IN(0), MOD + 0 * D, MOD + 1 * D, U, gw, NGW, lane); }
    PH_END();

    for (int l = 0; l < DEPTH; ++l) {
#define WL() (ws + WS_W + (size_t)l * W_LAYER)
#define MODL() (MOD + (size_t)l * BATCH * NMOD)
        for (int rep_ = 0; rep_ < REP_GEMM * REP_G_IN; ++rep_) {
        if (PH_ON()) { PH_LOCALS();
            pg8::Gemm g{U, (const bf16*)(WL() + WO_IN), M, NP, D}; pg8::StaticOrder S; S.init(M, NP, G, bx);
            pg8::EpiBf16<0> E{P, NP, nullptr};
            pg8::gemm_phase<pg8::EpiBf16<0>, pg8::StaticOrder, true, true>(L + RING_OFF, tid, g, S, E);
            for (int r2_ = 0; r2_ < REP_GLR; ++r2_) glr_mfma(U, (const bf16*)(WL() + WO_GLR), GLR, L, tid, vcu, G);
        }
        PH_END(); }
#define RG_ARGS() IN(5) + (size_t)l * 4 * D_RG, IN(6) + (size_t)l * D_RG, IN(7) + (size_t)l * D_RG * RG_BW, IN(8) + (size_t)l * D_RG, IN(9) + (size_t)l * D_RG * RG_BW, IN(10) + (size_t)l * D_RG, IN(11) + (size_t)l * D_RG, (float*)(ws + WS_RGAGG), CC
#define GLA_ARGS() GLR, IN(12) + (size_t)l * GLA_RANK * GLA_DK, IN(13) + (size_t)l * GLA_DK, IN(14) + (size_t)l * GLA_DV, (float*)(ws + WS_SLOC), (float*)(ws + WS_DSEG), CC
        for (int rep_ = 0; rep_ < REP_MIX; ++rep_) {
        if (PH_ON()) { PH_LOCALS();
            for (int r2_ = 0; r2_ < REP_RG1; ++r2_) for (int unit = vcu; unit < BATCH * 8 * RG_SEGS; unit += G) rg_unit<false>(L, tid, unit, P, RG_ARGS());
            for (int r2_ = 0; r2_ < REP_GLA1; ++r2_) for (int unit = vcu; unit < BATCH * GLA_H * GLA_SEGS; unit += G) gla_unit<false>(L, tid, unit, P, GLA_ARGS()); }
        PH_END();
        if (PH_ON()) { PH_LOCALS(); gla_prefix((float*)(ws + WS_SLOC), (const float*)(ws + WS_DSEG), gt, NT); }
        PH_END();
        if (PH_ON()) { PH_LOCALS();
            for (int r2_ = 0; r2_ < REP_RG2; ++r2_) for (int unit = vcu; unit < BATCH * 8 * RG_SEGS; unit += G) rg_unit<true>(L, tid, unit, P, RG_ARGS());
            for (int r2_ = 0; r2_ < REP_GLA2; ++r2_) for (int unit = vcu; unit < BATCH * GLA_H * GLA_SEGS; unit += G) gla_unit<true>(L, tid, unit, P, GLA_ARGS()); }
        PH_END(); }
        for (int rep_ = 0; rep_ < REP_GEMM * REP_G_OUT; ++rep_) {
        if (PH_ON()) { PH_LOCALS();
            const float* const xprev = (l == 0) ? IN(0) : karg_out();
            pg8::Gemm g{CC, (const bf16*)(WL() + WO_OUT), M, D, D}; pg8::StaticOrder S; S.init(M, D, G, bx);
            pg8::EpiRes E{V, D, nullptr, xprev, MODL() + 2 * D, NMOD, SEQ / 256, ALPHA};
            pg8::gemm_phase<pg8::EpiRes, pg8::StaticOrder, true, true>(L + RING_OFF, tid, g, S, E);
        }
        PH_END(); }
        for (int rep_ = 0; rep_ < REP_LN; ++rep_) {
        if (PH_ON()) { PH_LOCALS(); ln_rows(V, IN(16) + (size_t)l * D, IN(17) + (size_t)l * D, X1, MODL() + 3 * D, MODL() + 4 * D, U, gw, NGW, lane); }
        PH_END(); }
        for (int rep_ = 0; rep_ < REP_GEMM * REP_G_UP; ++rep_) {
        if (PH_ON()) { PH_LOCALS();
            pg8::Gemm g{U, (const bf16*)(WL() + WO_UP), M, FF, D}; pg8::StaticOrder S; S.init(M, FF, G, bx);
            pg8::EpiBf16<3> E{HDN, FF, IN(19) + (size_t)l * FF};
            pg8::gemm_phase<pg8::EpiBf16<3>, pg8::StaticOrder, true, true>(L + RING_OFF, tid, g, S, E);
        }
        PH_END(); }
        for (int rep_ = 0; rep_ < REP_GEMM * REP_G_DOWN; ++rep_) {
        if (PH_ON()) { PH_LOCALS();
            pg8::Gemm g{HDN, (const bf16*)(WL() + WO_DOWN), M, D, FF}; pg8::StaticOrder S; S.init(M, D, G, bx);
            pg8::EpiRes E{V, D, IN(21) + (size_t)l * D, X1, MODL() + 5 * D, NMOD, SEQ / 256, ALPHA};
            pg8::gemm_phase<pg8::EpiRes, pg8::StaticOrder, true, true>(L + RING_OFF, tid, g, S, E);
        }
        PH_END(); }
        for (int rep_ = 0; rep_ < REP_LN; ++rep_) {
        if (PH_ON()) { PH_LOCALS();
            const bool more = (l + 1 < DEPTH); const float* modn = MOD + (size_t)(more ? l + 1 : l) * BATCH * NMOD;
            ln_rows(V, IN(22) + (size_t)l * D, IN(23) + (size_t)l * D, karg_out(), modn + 0 * D, modn + 1 * D, more ? U : (bf16*)nullptr, gw, NGW, lane);
        }
        PH_END(); }
    }
    if (!MK_LAUNCH_PER_PHASE) {
        if (bx0 == 0 && MK_TID() == 0 && __hip_atomic_load((gu32*)((unsigned*)(karg_ws() + WS_CTL) + CW_BAR + XB_TMO), RLX_AGENT) != 0u) karg_out()[0] = __builtin_nanf("");
    }
#undef PH_ON
#undef PH_END
}
constexpr int N_PHASES = 2 + DEPTH * 9;

extern "C" void kernel_launch(void* const* d_in, const int* in_sizes, int n_in, void* d_out, int out_size, void* d_ws, size_t ws_size, hipStream_t stream) {
    static int grid = 0;
    if (grid == 0) {
        if (n_in != 24 || in_sizes[0] != M * D || out_size != M * D || ws_size < WS_END) { fprintf(stderr, "kernel_launch: unexpected shapes / workspace: n_in %d in0 %d out %d ws %zu (need %zu)\n", n_in, n_in > 0 ? in_sizes[0] : -1, out_size, ws_size, (size_t)WS_END); grid = -1; return; }
        int dev = 0, cus = 0, per_cu = 0;
        if (hipGetDevice(&dev) != hipSuccess || hipDeviceGetAttribute(&cus, hipDeviceAttributeMultiprocessorCount, dev) != hipSuccess) { fprintf(stderr, "kernel_launch: device query failed\n"); grid = -1; return; }
        if (hipFuncSetAttribute((const void*)mk_fwd, hipFuncAttributeMaxDynamicSharedMemorySize, LDS_BYTES) != hipSuccess) { fprintf(stderr, "kernel_launch: hipFuncSetAttribute failed\n"); grid = -1; return; }
        if (hipOccupancyMaxActiveBlocksPerMultiprocessor(&per_cu, (const void*)mk_fwd, NWAVES * 64, LDS_BYTES) != hipSuccess || per_cu < 1)
            fprintf(stderr, "kernel_launch: note: occupancy query reports %d workgroups per CU\n", per_cu);
        (void)hipGetLastError();
        grid = cus;
    }
    if (grid < 0) return;
    if (hipMemsetAsync((char*)d_ws + WS_CTL, 0, CTL_ZERO_BYTES, stream) != hipSuccess) { fprintf(stderr, "kernel_launch: memset failed\n"); return; }
    Args a{};
    for (int i = 0; i < 24; ++i) a.in[i] = (const float*)d_in[i];
    a.out = (float*)d_out; a.ws = (unsigned char*)d_ws;
#if MK_LAUNCH_PER_PHASE
    for (int p = 0; p < N_PHASES; ++p) { a.ph_lo = p; a.ph_hi = p + 1; hipLaunchKernelGGL(mk_fwd, dim3(grid), dim3(NWAVES * 64), LDS_BYTES, stream, a); }
#else
    a.ph_lo = 0; a.ph_hi = N_PHASES;
    hipLaunchKernelGGL(mk_fwd, dim3(grid), dim3(NWAVES * 64), LDS_BYTES, stream, a);
#endif
    const hipError_t le = hipPeekAtLastError();
    if (le != hipSuccess) fprintf(stderr, "kernel_launch: launch failed: %s\n", hipGetErrorName(le));
}
```
